# Optimizing an MI355X kernel written in HIP

```python
import jax
import jax.numpy as jnp
from jax import lax
import numpy as np

D_MODEL = 1024
BATCH = 4
SEQ = 4096
DEPTH = 2

GRID_W = 64
CTX_LEN = 256

NA_HEADS = 8
NA_HEAD_DIM = 64
NA_WIDTH = NA_HEADS * NA_HEAD_DIM
NA_WIN_ROWS = 8
NA_WIN_COLS = 16
ROPE_BASE = 10000.0
SC_WIDTH = 512
SC_CONV = 3
LRU_WIDTH = 512
LRU_BLOCKS = 8
LRU_BLOCK_DIM = LRU_WIDTH // LRU_BLOCKS
LRU_CONV = 4
LRU_C = 8.0
N_BRANCHES = 3
SPLIT_SIZES = (NA_WIDTH, NA_WIDTH, NA_WIDTH, SC_WIDTH, SC_WIDTH, SC_WIDTH,
               LRU_WIDTH, LRU_WIDTH, N_BRANCHES * D_MODEL)
P_TOTAL = sum(SPLIT_SIZES)
N_EXPERTS = 32
TOP_K = 4
D_EXPERT = D_MODEL
SWIGLU_LIMIT = 7.0
SWIGLU_ALPHA = 1.702
MOE_BLOCK = 128
LN_EPS = 1e-5
MOD_SCALE = 0.5
DEEPNORM_ALPHA = (2 * DEPTH) ** 0.25
DEEPNORM_BETA = (8 * DEPTH) ** -0.25

kernel_name = "hybrid_na_shortconv_rglru_moe_diffusion"


def layer_norm(x, gain=None, bias=None):
    xf = x.astype(jnp.float32)
    mu = jnp.mean(xf, axis=-1, keepdims=True)
    var = jnp.mean(jnp.square(xf - mu), axis=-1, keepdims=True)
    y = (xf - mu) * lax.rsqrt(var + LN_EPS)
    if gain is not None:
        y = y * gain.astype(jnp.float32) + bias.astype(jnp.float32)
    return y.astype(x.dtype)


def modulate(x, shift, scale):
    return x * (1.0 + scale) + shift


def depthwise_conv(u, w, pad_left, pad_right):
    return lax.conv_general_dilated(
        u, w.astype(u.dtype)[:, None, :], window_strides=(1,),
        padding=[(pad_left, pad_right)], dimension_numbers=("NWC", "WIO", "NWC"),
        feature_group_count=u.shape[-1])


def rope_1d(x, pos):
    m = x.shape[-1] // 2
    inv_freq = ROPE_BASE ** (-jnp.arange(m, dtype=jnp.float32) / m)
    ang = pos.astype(jnp.float32)[:, None] * inv_freq[None, :]
    cos = jnp.cos(ang)[None, :, None, :]
    sin = jnp.sin(ang)[None, :, None, :]
    xf = x.astype(jnp.float32)
    x1, x2 = xf[..., :m], xf[..., m:]
    return jnp.concatenate([x1 * cos - x2 * sin, x1 * sin + x2 * cos], axis=-1).astype(x.dtype)


def axial_rope(x, row_pos, col_pos):
    half = x.shape[-1] // 2
    return jnp.concatenate([rope_1d(x[..., :half], row_pos), rope_1d(x[..., half:], col_pos)], axis=-1)


def neighbourhood_attention(q, k, v, k_ctx, v_ctx, rpb):
    bsz, seq, heads, dh = q.shape
    rows = seq // GRID_W
    kr = min(NA_WIN_ROWS, rows)
    kc = NA_WIN_COLS
    n_loc = kr * kc
    scale = dh ** -0.5
    q5 = q.reshape(bsz, rows, GRID_W, heads, dh)
    k5 = k.reshape(bsz, rows, GRID_W, heads, dh)
    v5 = v.reshape(bsz, rows, GRID_W, heads, dh)
    cols = jnp.arange(GRID_W)
    col_start = jnp.clip(cols - kc // 2, 0, GRID_W - kc)
    col_idx = col_start[:, None] + jnp.arange(kc)[None, :]
    dc_idx = col_idx - cols[:, None] + (NA_WIN_COLS - 1)

    def row_block(r):
        r0 = jnp.clip(r - kr // 2, 0, rows - kr)
        dr_idx = r0 + jnp.arange(kr) - r + (NA_WIN_ROWS - 1)
        bias = rpb[:, dr_idx[None, :, None], dc_idx[:, None, :]].reshape(heads, GRID_W, n_loc)
        q_r = lax.dynamic_index_in_dim(q5, r, axis=1, keepdims=False)
        k_band = lax.dynamic_slice_in_dim(k5, r0, kr, axis=1)
        v_band = lax.dynamic_slice_in_dim(v5, r0, kr, axis=1)
        k_loc = k_band[:, :, col_idx].transpose(0, 2, 1, 3, 4, 5).reshape(bsz, GRID_W, n_loc, heads, dh)
        v_loc = v_band[:, :, col_idx].transpose(0, 2, 1, 3, 4, 5).reshape(bsz, GRID_W, n_loc, heads, dh)
        s_loc = jnp.einsum("bwhd,bwnhd->bhwn", q_r, k_loc).astype(jnp.float32) * scale \
            + bias.astype(jnp.float32)[None]
        s_ctx = jnp.einsum("bwhd,bchd->bhwc", q_r, k_ctx).astype(jnp.float32) * scale
        p = jax.nn.softmax(jnp.concatenate([s_loc, s_ctx], axis=-1), axis=-1).astype(v.dtype)
        return (jnp.einsum("bhwn,bwnhd->bwhd", p[..., :n_loc], v_loc)
                + jnp.einsum("bhwc,bchd->bwhd", p[..., n_loc:], v_ctx))

    o = lax.map(row_block, jnp.arange(rows))
    return o.transpose(1, 0, 2, 3, 4).reshape(bsz, seq, heads * dh)


def context_attention(q, k, v):
    bsz, n, heads, dh = q.shape
    s = jnp.einsum("bqhd,bkhd->bhqk", q, k).astype(jnp.float32) * dh ** -0.5
    p = jax.nn.softmax(s, axis=-1).astype(v.dtype)
    return jnp.einsum("bhqk,bkhd->bqhd", p, v).reshape(bsz, n, heads * dh)


def short_conv(b_gate, c_gate, xs, w):
    return b_gate * depthwise_conv(c_gate * xs, w, 1, 1)


def rglru_coeffs(xm, lam, w_r, b_r, w_i, b_i):
    bsz, seq, ch = xm.shape
    xb = xm.reshape(bsz, seq, LRU_BLOCKS, LRU_BLOCK_DIM)
    r = jax.nn.sigmoid(jnp.einsum("blnd,nde->blne", xb, w_r).reshape(bsz, seq, ch) + b_r).astype(jnp.float32)
    i = jax.nn.sigmoid(jnp.einsum("blnd,nde->blne", xb, w_i).reshape(bsz, seq, ch) + b_i)
    log_a = -LRU_C * jax.nn.softplus(-lam.astype(jnp.float32)) * r
    a = jnp.exp(log_a)
    b = jnp.sqrt(-jnp.expm1(2.0 * log_a)) * (i * xm).astype(jnp.float32)
    return a, b


def linear_scan(a, b, h0, reverse):
    edge = -1 if reverse else 0
    b = b.at[:, edge].add(a[:, edge] * h0)

    def combine(earlier, later):
        a_e, b_e = earlier
        a_l, b_l = later
        return a_e * a_l, a_l * b_e + b_l

    return lax.associative_scan(combine, (a, b), reverse=reverse, axis=1)[1]


def rglru_bidirectional(xm, xm_ctx, lam, w_r, b_r, w_i, b_i):
    h_lat, h_ctx = [], []
    for d, reverse in ((0, False), (1, True)):
        a_c, b_c = rglru_coeffs(xm_ctx, lam[d], w_r[d], b_r[d], w_i[d], b_i[d])
        hc = linear_scan(a_c, b_c, jnp.zeros_like(b_c[:, 0]), reverse)
        state = hc[:, 0] if reverse else hc[:, -1]
        a_l, b_l = rglru_coeffs(xm, lam[d], w_r[d], b_r[d], w_i[d], b_i[d])
        h_lat.append(linear_scan(a_l, b_l, state, reverse))
        h_ctx.append(hc)
    return (h_lat[0] + h_lat[1]).astype(xm.dtype), (h_ctx[0] + h_ctx[1]).astype(xm.dtype)


def merge_branches(gate_logits, y_a, y_b, y_c):
    g = jax.nn.sigmoid(gate_logits.reshape(gate_logits.shape[:-1] + (N_BRANCHES, D_MODEL)))
    return g[..., 0, :] * y_a + g[..., 1, :] * y_b + g[..., 2, :] * y_c


def mixer_sublayer(u, u_ctx, with_ctx_out, w_in, b_in, rpb, w_pa, w_pc, w_pl, sc_w,
                   lru_cw, lru_cb, lam, w_r, b_r, w_i, b_i, w_o, b_o):
    bsz, seq, _ = u.shape
    points = [int(p) for p in np.cumsum(SPLIT_SIZES)[:-1]]
    q, k, v, sb, scg, sx, lx, lg, gl = jnp.split(u @ w_in + b_in, points, axis=-1)
    qc, kc, vc, sbc, scgc, sxc, lxc, lgc, glc = jnp.split(u_ctx @ w_in + b_in, points, axis=-1)

    def heads(t):
        return t.reshape(t.shape[0], t.shape[1], NA_HEADS, NA_HEAD_DIM)

    t = jnp.arange(seq)
    row_pos, col_pos = t // GRID_W, t % GRID_W
    y_a = neighbourhood_attention(axial_rope(heads(q), row_pos, col_pos),
                                  axial_rope(heads(k), row_pos, col_pos),
                                  heads(v), heads(kc), heads(vc), rpb) @ w_pa
    y_b = short_conv(sb, scg, sx, sc_w) @ w_pc
    xm = depthwise_conv(lx, lru_cw, LRU_CONV // 2, LRU_CONV - 1 - LRU_CONV // 2) + lru_cb
    xm_c = depthwise_conv(lxc, lru_cw, LRU_CONV // 2, LRU_CONV - 1 - LRU_CONV // 2) + lru_cb
    h_lat, h_ctx = rglru_bidirectional(xm, xm_c, lam, w_r, b_r, w_i, b_i)
    y_c = (jax.nn.gelu(lg) * h_lat) @ w_pl
    out = merge_branches(gl, y_a, y_b, y_c) @ w_o + b_o
    if not with_ctx_out:
        return out, None
    y_a_c = context_attention(heads(qc), heads(kc), heads(vc)) @ w_pa
    y_b_c = short_conv(sbc, scgc, sxc, sc_w) @ w_pc
    y_c_c = (jax.nn.gelu(lgc) * h_ctx) @ w_pl
    out_c = merge_branches(glc, y_a_c, y_b_c, y_c_c) @ w_o + b_o
    return out, out_c


def routed_experts(tok, router_w, router_b, w_gu, b_gu, w_dn, b_dn):
    n_tok, d = tok.shape
    logits = (tok @ router_w + router_b).astype(jnp.float32)
    top_logits, top_idx = lax.top_k(logits, TOP_K)
    top_p = jax.nn.softmax(top_logits, axis=-1)
    n_assign = n_tok * TOP_K
    flat_e = top_idx.reshape(-1)
    flat_tok = jnp.repeat(jnp.arange(n_tok, dtype=jnp.int32), TOP_K)
    flat_p = top_p.reshape(-1)
    order = jnp.argsort(flat_e)
    s_e, s_tok, s_p = flat_e[order], flat_tok[order], flat_p[order]
    counts = jnp.bincount(flat_e, length=N_EXPERTS)
    padded = (counts + MOE_BLOCK - 1) // MOE_BLOCK * MOE_BLOCK
    start = jnp.cumsum(counts) - counts
    pad_end = jnp.cumsum(padded)
    pad_start = pad_end - padded
    dest = pad_start[s_e] + jnp.arange(n_assign) - start[s_e]
    n_blocks = -(-n_assign // MOE_BLOCK) + N_EXPERTS
    n_slots = n_blocks * MOE_BLOCK
    slot_tok = jnp.zeros((n_slots,), jnp.int32).at[dest].set(s_tok)
    slot_p = jnp.zeros((n_slots,), tok.dtype).at[dest].set(s_p.astype(tok.dtype))
    block_e = jnp.minimum(jnp.searchsorted(pad_end, jnp.arange(n_blocks) * MOE_BLOCK, side="right"),
                          N_EXPERTS - 1)
    x_blocks = tok[slot_tok].reshape(n_blocks, MOE_BLOCK, d)

    def expert_block(args):
        xb, e = args
        gate, up = jnp.split(xb @ w_gu[e] + b_gu[e], 2, axis=-1)
        gate = jnp.minimum(gate, SWIGLU_LIMIT)
        up = jnp.clip(up, -SWIGLU_LIMIT, SWIGLU_LIMIT)
        hid = (up + 1.0) * gate * jax.nn.sigmoid(SWIGLU_ALPHA * gate)
        return hid @ w_dn[e] + b_dn[e]

    y_blocks = lax.map(expert_block, (x_blocks, block_e))
    return jnp.zeros_like(tok).at[slot_tok].add(y_blocks.reshape(n_slots, d) * slot_p[:, None])


def setup_inputs(seed: int = 0) -> dict:
    key = jax.random.key(seed)
    ks = iter(jax.random.split(key, 40))

    def nrm(shape, scale):
        return jax.random.normal(next(ks), shape, jnp.float32) * scale

    d, f = D_MODEL, D_EXPERT
    a_c = jax.random.uniform(next(ks), (DEPTH, 2, LRU_WIDTH), jnp.float32, minval=0.9, maxval=0.999)
    a_base = a_c ** (1.0 / LRU_C)
    return {
        "x": nrm((BATCH, SEQ, d), 1.0),
        "c": nrm((BATCH, d), 1.0),
        "ctx": nrm((BATCH, CTX_LEN, d), 1.0),
        "c_ctx": nrm((d,), 1.0),
        "w_mod": nrm((DEPTH, d, 6 * d), MOD_SCALE * d ** -0.5),
        "b_mod": nrm((DEPTH, 6 * d), 0.02),
        "w_in": nrm((DEPTH, d, P_TOTAL), d ** -0.5),
        "b_in": nrm((DEPTH, P_TOTAL), 0.02),
        "na_rpb": nrm((DEPTH, NA_HEADS, 2 * NA_WIN_ROWS - 1, 2 * NA_WIN_COLS - 1), 0.1),
        "w_proj_attn": nrm((DEPTH, NA_WIDTH, d), DEEPNORM_BETA * NA_WIDTH ** -0.5),
        "w_proj_conv": nrm((DEPTH, SC_WIDTH, d), DEEPNORM_BETA * SC_WIDTH ** -0.5),
        "w_proj_lru": nrm((DEPTH, LRU_WIDTH, d), DEEPNORM_BETA * LRU_WIDTH ** -0.5),
        "sc_conv_w": nrm((DEPTH, SC_CONV, SC_WIDTH), SC_CONV ** -0.5),
        "lru_conv_w": nrm((DEPTH, LRU_CONV, LRU_WIDTH), LRU_CONV ** -0.5),
        "lru_conv_b": nrm((DEPTH, LRU_WIDTH), 0.02),
        "lru_lambda": jnp.log(a_base) - jnp.log1p(-a_base),
        "lru_w_r": nrm((DEPTH, 2, LRU_BLOCKS, LRU_BLOCK_DIM, LRU_BLOCK_DIM), LRU_BLOCK_DIM ** -0.5),
        "lru_b_r": nrm((DEPTH, 2, LRU_WIDTH), 0.02),
        "lru_w_i": nrm((DEPTH, 2, LRU_BLOCKS, LRU_BLOCK_DIM, LRU_BLOCK_DIM), LRU_BLOCK_DIM ** -0.5),
        "lru_b_i": nrm((DEPTH, 2, LRU_WIDTH), 0.02),
        "w_o": nrm((DEPTH, d, d), DEEPNORM_BETA * d ** -0.5),
        "b_o": nrm((DEPTH, d), 0.02),
        "ln1_g": 1.0 + nrm((DEPTH, d), 0.02),
        "ln1_b": nrm((DEPTH, d), 0.02),
        "router_w": nrm((DEPTH, d, N_EXPERTS), d ** -0.5),
        "router_b": nrm((DEPTH, N_EXPERTS), 0.01),
        "exp_w_gu": nrm((DEPTH, N_EXPERTS, d, 2 * f), d ** -0.5),
        "exp_b_gu": nrm((DEPTH, N_EXPERTS, 2 * f), 0.02),
        "exp_w_dn": nrm((DEPTH, N_EXPERTS, f, d), DEEPNORM_BETA * f ** -0.5),
        "exp_b_dn": nrm((DEPTH, N_EXPERTS, d), 0.02),
        "ln2_g": 1.0 + nrm((DEPTH, d), 0.02),
        "ln2_b": nrm((DEPTH, d), 0.02),
    }


def reference(x, c, ctx, c_ctx, w_mod, b_mod, w_in, b_in, na_rpb, w_proj_attn, w_proj_conv,
              w_proj_lru, sc_conv_w, lru_conv_w, lru_conv_b, lru_lambda, lru_w_r, lru_b_r,
              lru_w_i, lru_b_i, w_o, b_o, ln1_g, ln1_b, router_w, router_b, exp_w_gu,
              exp_b_gu, exp_w_dn, exp_b_dn, ln2_g, ln2_b):
    bsz, seq, d = x.shape
    n_ctx = ctx.shape[1]
    h, h_c = x, ctx
    for layer in range(DEPTH):
        last = layer == DEPTH - 1
        mod = jax.nn.silu(c) @ w_mod[layer] + b_mod[layer]
        mod_c = jax.nn.silu(c_ctx) @ w_mod[layer] + b_mod[layer]
        sh1, sc1, g1, sh2, sc2, g2 = jnp.split(mod[:, None, :], 6, axis=-1)
        csh1, csc1, cg1, csh2, csc2, cg2 = jnp.split(mod_c, 6, axis=-1)
        y, y_c = mixer_sublayer(
            modulate(layer_norm(h), sh1, sc1), modulate(layer_norm(h_c), csh1, csc1), not last,
            w_in[layer], b_in[layer], na_rpb[layer], w_proj_attn[layer], w_proj_conv[layer],
            w_proj_lru[layer], sc_conv_w[layer], lru_conv_w[layer], lru_conv_b[layer],
            lru_lambda[layer], lru_w_r[layer], lru_b_r[layer], lru_w_i[layer], lru_b_i[layer],
            w_o[layer], b_o[layer])
        h = layer_norm(DEEPNORM_ALPHA * h + g1 * y, ln1_g[layer], ln1_b[layer])
        u2 = modulate(layer_norm(h), sh2, sc2).reshape(bsz * seq, d)
        if last:
            y2 = routed_experts(u2, router_w[layer], router_b[layer], exp_w_gu[layer],
                                exp_b_gu[layer], exp_w_dn[layer], exp_b_dn[layer]).reshape(bsz, seq, d)
        else:
            h_c = layer_norm(DEEPNORM_ALPHA * h_c + cg1 * y_c, ln1_g[layer], ln1_b[layer])
            u2c = modulate(layer_norm(h_c), csh2, csc2).reshape(bsz * n_ctx, d)
            y2_all = routed_experts(jnp.concatenate([u2, u2c], axis=0), router_w[layer], router_b[layer],
                                    exp_w_gu[layer], exp_b_gu[layer], exp_w_dn[layer], exp_b_dn[layer])
            y2 = y2_all[:bsz * seq].reshape(bsz, seq, d)
            h_c = layer_norm(DEEPNORM_ALPHA * h_c + cg2 * y2_all[bsz * seq:].reshape(bsz, n_ctx, d),
                             ln2_g[layer], ln2_b[layer])
        h = layer_norm(DEEPNORM_ALPHA * h + g2 * y2, ln2_g[layer], ln2_b[layer])
    return h
```

```cpp
#include <hip/hip_runtime.h>
#include <hip/hip_cooperative_groups.h>
#include <cstdio>
#include <cstdint>
namespace cg = cooperative_groups;

typedef unsigned short bf16_t;
typedef short bf16x8 __attribute__((ext_vector_type(8)));
typedef float f32x4 __attribute__((ext_vector_type(4)));
typedef float f32x2 __attribute__((ext_vector_type(2)));
typedef unsigned u32x4 __attribute__((ext_vector_type(4)));
typedef unsigned u32x2 __attribute__((ext_vector_type(2)));
#define LAS __attribute__((address_space(3)))

constexpr int D = 1024, NB = 4, SEQ = 4096, CTX = 256, NLAT = NB * SEQ, NCTX = NB * CTX, T = NLAT + NCTX;
constexpr int PT = 7168, GW = 64;
constexpr int C_Q = 0, C_K = 512, C_V = 1024, C_SB = 1536, C_SCG = 2048, C_SX = 2560, C_LX = 3072, C_LG = 3584, C_GL = 4096;
constexpr int NE = 32, NSLOT = 77824, ECAP = T;
constexpr float LN_EPS = 1e-5f, ALPHA = 1.41421356237f;
constexpr int NWAVES = 8, NTHR = 512;
constexpr int LDS_BYTES = 163840;
constexpr int LDS_CTRL = 163584, LDS_LN1 = 148480;

constexpr size_t MiB = 1u << 20;
constexpr size_t WS_CTL = 0, WS_MODP = 1 * MiB, WS_MOD = 5 * MiB, WS_ROPE = 6 * MiB, WS_WIN = 8 * MiB, WS_WPA = 36 * MiB, WS_WPC = 38 * MiB, WS_WPL = 40 * MiB,
                 WS_WO = 42 * MiB, WS_WGU = 46 * MiB, WS_WDN = 302 * MiB, WS_H = 430 * MiB, WS_V = 498 * MiB, WS_U = 566 * MiB, WS_P = 600 * MiB, WS_ATT = 838 * MiB,
                 WS_SC = 855 * MiB, WS_LRU = 872 * MiB, WS_MERGED = 889 * MiB, WS_SMALL = 923 * MiB, WS_XM = 927 * MiB, WS_RA = 961 * MiB, WS_RB = 1165 * MiB, WS_WPL2 = 1469 * MiB, WS_ETOK = 1473 * MiB, WS_WCAT = 1478 * MiB, WS_END = 1486 * MiB;
constexpr size_t WS_CAT = WS_RB;
constexpr size_t WS_VT = WS_LRU;
constexpr size_t WS_LRU2 = WS_XM;
#define GAS __attribute__((address_space(1)))
struct Params {
    const GAS float* in[32];
    GAS float* out;
    GAS unsigned char* ws;
};

__device__ __forceinline__ float bf2f(unsigned v) { return __uint_as_float(v << 16); }
__device__ __forceinline__ unsigned f2bf(float f) { unsigned u = __float_as_uint(f); return (u + 0x7fffu + ((u >> 16) & 1u)) >> 16; }
typedef __bf16 bf16x2_t __attribute__((ext_vector_type(2)));
__device__ __forceinline__ unsigned pk2(float lo, float hi) { const f32x2 v = {lo, hi}; const bf16x2_t b = __builtin_convertvector(v, bf16x2_t); return __builtin_bit_cast(unsigned, b); }
__device__ __forceinline__ float sigmoidf_(float x) { return __builtin_amdgcn_rcpf(1.0f + __expf(-x)); }
__device__ __forceinline__ float wave_sum(float v, int lane) {
    (void)lane;
    v += __int_as_float(__builtin_amdgcn_update_dpp(0, __float_as_int(v), 0xB1, 0xF, 0xF, true));
    v += __int_as_float(__builtin_amdgcn_update_dpp(0, __float_as_int(v), 0x4E, 0xF, 0xF, true));
    v += __int_as_float(__builtin_amdgcn_update_dpp(0, __float_as_int(v), 0x124, 0xF, 0xF, true));
    v += __int_as_float(__builtin_amdgcn_update_dpp(0, __float_as_int(v), 0x128, 0xF, 0xF, true));
    const float r0 = __int_as_float(__builtin_amdgcn_readlane(__float_as_int(v), 0)), r1 = __int_as_float(__builtin_amdgcn_readlane(__float_as_int(v), 16));
    const float r2 = __int_as_float(__builtin_amdgcn_readlane(__float_as_int(v), 32)), r3 = __int_as_float(__builtin_amdgcn_readlane(__float_as_int(v), 48));
    return (r0 + r1) + (r2 + r3);
}
__device__ __forceinline__ float bperm(int srclane, float v) { return __int_as_float(__builtin_amdgcn_ds_bpermute(srclane << 2, __float_as_int(v))); }
__device__ __forceinline__ void unpack8(const u32x4 w, float* f) {
    f[0] = bf2f(w.x & 0xffffu); f[1] = bf2f(w.x >> 16); f[2] = bf2f(w.y & 0xffffu); f[3] = bf2f(w.y >> 16);
    f[4] = bf2f(w.z & 0xffffu); f[5] = bf2f(w.z >> 16); f[6] = bf2f(w.w & 0xffffu); f[7] = bf2f(w.w >> 16);
}
__device__ __forceinline__ u32x4 pack8(const float* f) { u32x4 w; w.x = pk2(f[0], f[1]); w.y = pk2(f[2], f[3]); w.z = pk2(f[4], f[5]); w.w = pk2(f[6], f[7]); return w; }
__device__ __forceinline__ int perm32(int rho) { const int n = rho >> 4, i = rho & 15; return 8 * (i >> 2) + 4 * n + (i & 3); }
__device__ __forceinline__ float gelu_tanh(float x) { const float u = 0.7978845608028654f * (x + 0.044715f * x * x * x); return 0.5f * x * (1.0f + tanhf(u)); }

struct Unit { int pm, pn, aux, nvalid; const bf16_t* A; const bf16_t* B; const int* idx; };
#define PG8_LAS __attribute__((address_space(3)))
constexpr int BM = 256, BK = 64, HALF = 128, HTB = HALF * BK * 2, STAGE_BYTES = 8 * HTB;
__host__ __device__ __forceinline__ int lds_byte(int r, int c) { const int st = (r >> 4) * 2 + (c >> 5), rr = r & 15, cc = c & 31, ob = rr * 64 + cc * 2; return st * 1024 + (ob ^ (((ob >> 9) & 1) << 5)); }
__host__ __device__ __forceinline__ void stage_rc(int b, int& R, int& C) { const int st = b / 1024, sb = b % 1024, swz = sb ^ (((sb >> 9) & 1) << 5); R = (st >> 1) * 16 + swz / 64; C = (st & 1) * 32 + (swz % 64) / 2; }
template <class Epi, class Sched>
__device__ __forceinline__ void gemm_pg8(PG8_LAS unsigned char* lds, int tid, const int K, const Sched& S, const Epi& E) {
    const int wid = __builtin_amdgcn_readfirstlane(tid >> 6), lane = tid & 63, wr = wid >> 2, wc = wid & 3, fr = lane & 15, fq = lane >> 4;
    const int nt = K / BK;
    unsigned voffB[2]; int RA[2], CA[2];
#pragma unroll
    for (int i = 0; i < 2; ++i) { int R, Cc; stage_rc(tid * 16 + i * 8192, R, Cc); const int Rb = Epi::PERM ? ((R & ~31) + perm32(R & 31)) : R;
        RA[i] = R; CA[i] = Cc; voffB[i] = (unsigned)(Rb * K + Cc) * 2u; }
    const size_t kstep = (size_t)(BK * 2);
    const size_t hstep = (size_t)HALF * K * 2;
    const unsigned ldsw = (unsigned)wid * 1024u;
    const int aoff = lds_byte(wr * 64 + fr, fq * 8), boff = lds_byte(wc * 32 + fr, fq * 8);
#define PG8_SA(b, h) (((b) * 2 + (h)) * HTB)
#define PG8_SB(b, h) ((4 + (b) * 2 + (h)) * HTB)
#define PG8_STAGE(bufoff, gbase, voff) do { _Pragma("unroll") for (int _i = 0; _i < 2; ++_i) \
        __builtin_amdgcn_global_load_lds((const unsigned*)((const char*)(gbase) + (voff)[_i]), (PG8_LAS unsigned*)(lds + (bufoff) + ldsw + _i * 8192), 16, 0, 0); } while (0)
#define PG8_LDA(dst, b, h) do { _Pragma("unroll") for (int m = 0; m < 4; ++m) _Pragma("unroll") for (int k = 0; k < 2; ++k) dst[m][k] = *(const PG8_LAS bf16x8*)(lds + PG8_SA(b, h) + aoff + m * 2048 + k * 1024); } while (0)
#define PG8_LDB(dst, b, h) do { _Pragma("unroll") for (int n = 0; n < 2; ++n) _Pragma("unroll") for (int k = 0; k < 2; ++k) dst[n][k] = *(const PG8_LAS bf16x8*)(lds + PG8_SB(b, h) + boff + n * 2048 + k * 1024); } while (0)
#define PG8_MMA(ai, bj, At, Bt) do { __builtin_amdgcn_s_setprio(1); _Pragma("unroll") for (int m = 0; m < 4; ++m) _Pragma("unroll") for (int n = 0; n < 2; ++n) _Pragma("unroll") for (int k = 0; k < 2; ++k) \
        acc[ai][bj][m][n] = __builtin_amdgcn_mfma_f32_16x16x32_bf16(Bt[n][k], At[m][k], acc[ai][bj][m][n], 0, 0, 0); __builtin_amdgcn_s_setprio(0); } while (0)
#define PG8_WAIT_V(n) asm volatile("s_waitcnt vmcnt(" #n ")" ::: "memory")
#define PG8_WAIT_L(n) asm volatile("s_waitcnt lgkmcnt(" #n ")" ::: "memory")
#define PG8_BAR __builtin_amdgcn_s_barrier()
#define PG8_SCHED __builtin_amdgcn_sched_barrier(0)
#define PG8_VA(dst, u) do { _Pragma("unroll") for (int _h = 0; _h < 2; ++_h) _Pragma("unroll") for (int _i = 0; _i < 2; ++_i) { \
        if constexpr (Epi::GATHER) { const int _p = _h * HALF + RA[_i]; const int _tok = _p < (u).nvalid ? (u).idx[_p] : 0; dst[_h][_i] = (unsigned)(_tok * K + CA[_i]) * 2u; } \
        else dst[_h][_i] = (unsigned)((_h * HALF + RA[_i]) * K + CA[_i]) * 2u; } } while (0)
    Unit cur, nxt; int ui = 0;
    if (!S.next(0, cur)) return;
    f32x4 acc[2][2][4][2];
#pragma unroll
    for (int a = 0; a < 2; ++a)
#pragma unroll
        for (int b = 0; b < 2; ++b)
#pragma unroll
            for (int m = 0; m < 4; ++m)
#pragma unroll
                for (int n = 0; n < 2; ++n) acc[a][b][m][n] = (f32x4){0.f, 0.f, 0.f, 0.f};
    bf16x8 At[4][2], B0[2][2], B1[2][2];
    unsigned vAc[2][2], vAn[2][2];
    PG8_VA(vAc, cur);
    const char* cA = (const char*)cur.A; const char* cB = (const char*)cur.B;
    PG8_STAGE(PG8_SB(0, 0), cB, voffB); PG8_STAGE(PG8_SB(0, 1), cB + hstep, voffB); PG8_STAGE(PG8_SA(0, 0), cA, vAc[0]); PG8_STAGE(PG8_SA(0, 1), cA, vAc[1]);
    if (wr == 1) PG8_BAR;
    PG8_WAIT_V(2); PG8_BAR;
    PG8_STAGE(PG8_SB(1, 0), cB + kstep, voffB); PG8_STAGE(PG8_SA(1, 0), cA + kstep, vAc[0]); PG8_STAGE(PG8_SB(1, 1), cB + hstep + kstep, voffB);
    PG8_WAIT_V(6); PG8_BAR;
    for (;;) {
        const bool has_next = S.next(ui + 1, nxt);
        const char* nA = has_next ? (const char*)nxt.A : cA; const char* nB = has_next ? (const char*)nxt.B : cB;
        if (Epi::GATHER && has_next) PG8_VA(vAn, nxt);
        else {
#pragma unroll
            for (int h = 0; h < 2; ++h) { vAn[h][0] = vAc[h][0]; vAn[h][1] = vAc[h][1]; } }
        for (int t = 0; t < nt; t += 2) {
            const bool last = (t == nt - 2);
            const char* a1 = cA + (size_t)(t + 1) * kstep;
            const char* a2 = last ? nA : cA + (size_t)(t + 2) * kstep; const char* b2 = last ? nB : cB + (size_t)(t + 2) * kstep;
            const char* a3 = a2 + kstep; const char* b3 = b2 + kstep;
            unsigned v2[2][2];
#pragma unroll
            for (int h = 0; h < 2; ++h) { v2[h][0] = (Epi::GATHER && last) ? vAn[h][0] : vAc[h][0]; v2[h][1] = (Epi::GATHER && last) ? vAn[h][1] : vAc[h][1]; }
            PG8_LDB(B0, 0, 0); PG8_LDB(B1, 0, 1); PG8_SCHED; PG8_LDA(At, 0, 0); PG8_STAGE(PG8_SA(1, 1), a1, vAc[1]);
            PG8_WAIT_V(8); PG8_WAIT_L(0); PG8_BAR; PG8_MMA(0, 0, At, B0); PG8_MMA(0, 1, At, B1); PG8_BAR; PG8_SCHED;
            PG8_LDA(At, 0, 1); PG8_STAGE(PG8_SB(0, 0), b2, voffB); PG8_STAGE(PG8_SB(0, 1), b2 + hstep, voffB); PG8_STAGE(PG8_SA(0, 0), a2, v2[0]);
            PG8_WAIT_V(8); PG8_WAIT_L(0); PG8_BAR; PG8_MMA(1, 0, At, B0); PG8_MMA(1, 1, At, B1); PG8_BAR; PG8_SCHED;
            PG8_LDB(B0, 1, 0); PG8_LDB(B1, 1, 1); PG8_SCHED; PG8_LDA(At, 1, 0); PG8_STAGE(PG8_SA(0, 1), a2, v2[1]);
            PG8_WAIT_V(8); PG8_WAIT_L(0); PG8_BAR; PG8_MMA(0, 0, At, B0); PG8_MMA(0, 1, At, B1); PG8_BAR; PG8_SCHED;
            PG8_LDA(At, 1, 1); PG8_STAGE(PG8_SB(1, 0), b3, voffB); PG8_STAGE(PG8_SB(1, 1), b3 + hstep, voffB); PG8_STAGE(PG8_SA(1, 0), a3, v2[0]);
            PG8_WAIT_V(8); PG8_WAIT_L(0); PG8_BAR; PG8_MMA(1, 0, At, B0); PG8_MMA(1, 1, At, B1); PG8_BAR; PG8_SCHED;
            if constexpr (Epi::KHOOK) { if (t + 2 == Epi::HOOK0 || t + 2 == Epi::HOOK1) E.khook(acc, cur, t + 2, wr, wc, fr, fq); }
        }
        if (wr == 0) PG8_BAR;
        E(acc, cur, wr, wc, fr, fq);
        if (!has_next) break;
#pragma unroll
        for (int a = 0; a < 2; ++a)
#pragma unroll
            for (int b = 0; b < 2; ++b)
#pragma unroll
                for (int m = 0; m < 4; ++m)
#pragma unroll
                    for (int n = 0; n < 2; ++n) acc[a][b][m][n] = (f32x4){0.f, 0.f, 0.f, 0.f};
        cur = nxt; cA = nA; cB = nB; ++ui;
#pragma unroll
        for (int h = 0; h < 2; ++h) { vAc[h][0] = vAn[h][0]; vAc[h][1] = vAn[h][1]; }
        if (wr == 1) PG8_BAR;
    }
    PG8_WAIT_V(0);
    PG8_BAR;
#undef PG8_SA
#undef PG8_SB
#undef PG8_STAGE
#undef PG8_LDA
#undef PG8_LDB
#undef PG8_MMA
#undef PG8_WAIT_V
#undef PG8_WAIT_L
#undef PG8_BAR
#undef PG8_SCHED
#undef PG8_VA
}
__device__ __forceinline__ int xcd_chunk(int L, int nwg) { const int q = nwg / 8, r = nwg % 8, x = L % 8, off = L / 8; return (x < r ? x * (q + 1) : r * (q + 1) + (x - r) * q) + off; }
__device__ __forceinline__ void grouped_pm_pn(int wgid, int nM, int nN, int& pm, int& pn) {
    const int nig = 8 * nN, gid = wgid / nig, fm = gid * 8, gsz = (nM - fm) < 8 ? (nM - fm) : 8; pm = fm + ((wgid % nig) % gsz); pn = (wgid % nig) / gsz; }
struct Sched2D {
    const bf16_t* A; const bf16_t* B; int nM, nN, K, G, c;
    __device__ __forceinline__ bool next(int i, Unit& u) const {
        const int L = i * G + c, nwg = nM * nN; if (L >= nwg) return false;
        grouped_pm_pn(xcd_chunk(L, nwg), nM, nN, u.pm, u.pn); u.aux = 0; u.nvalid = 0; u.idx = nullptr; u.A = A + (size_t)u.pm * 256 * K; u.B = B + (size_t)u.pn * 256 * K; return true;
    }
};
struct SchedInProj {
    const bf16_t* A; const bf16_t* B; int G, c;
    __device__ __forceinline__ bool next(int i, Unit& u) const {
        const int L = i * G + c, nwg = (T / 256) * 26; if (L >= nwg) return false;
        int q; grouped_pm_pn(xcd_chunk(L, nwg), T / 256, 26, u.pm, q); u.pn = q < 4 ? q : q + 2; u.aux = 0; u.nvalid = 0; u.idx = nullptr;
        u.A = A + (size_t)u.pm * 256 * D; u.B = B + (size_t)u.pn * 256 * D; return true;
    }
};
struct SchedVT {
    const bf16_t* A; const bf16_t* B; int G, c;
    __device__ __forceinline__ bool next(int i, Unit& u) const {
        const int L0 = i * G + c, nwg = 2 * (T / 256); if (L0 >= nwg) return false;
        const int L = xcd_chunk(L0, nwg); u.pm = L & 1; u.pn = L >> 1; u.aux = 0; u.nvalid = 0; u.idx = nullptr; u.A = A + (size_t)u.pm * 256 * D; u.B = B + (size_t)u.pn * 256 * D; return true;
    }
};
struct EpiVT {
    static constexpr bool PERM = true, GATHER = false, KHOOK = false; static constexpr int HOOK0 = -1, HOOK1 = -1;
    bf16_t* VT; const float* bv;
    __device__ __forceinline__ void operator()(const f32x4 (&acc)[2][2][4][2], const Unit& u, int wr, int wc, int fr, int fq) const {
        const int row0 = u.pm * 256 + wr * 64 + fr, col0 = u.pn * 256 + wc * 32 + 8 * fq;
#pragma unroll
        for (int ai = 0; ai < 2; ++ai)
#pragma unroll
            for (int m = 0; m < 4; ++m) { const int row = row0 + ai * 128 + m * 16; const float bb = bv[row];
#pragma unroll
                for (int bj = 0; bj < 2; ++bj) { float o[8];
#pragma unroll
                    for (int n = 0; n < 2; ++n) { const f32x4 v = acc[ai][bj][m][n]; o[4 * n] = v[0] + bb; o[4 * n + 1] = v[1] + bb; o[4 * n + 2] = v[2] + bb; o[4 * n + 3] = v[3] + bb; }
                    *(u32x4*)(VT + (size_t)row * T + col0 + bj * 128) = pack8(o); } }
    }
};
struct SchedMoE {
    const bf16_t* A; const bf16_t* B; const LAS int* blk; int nN, K, G, c; size_t bstride; const int* etok; bool gather;
    __device__ __forceinline__ bool next(int i, Unit& u) const {
        const int L0 = i * G + c, nwg = blk[32] * nN; if (L0 >= nwg) return false;
        const int L = xcd_chunk(L0, nwg);
        int e = 0;
#pragma unroll 1
        for (int j = 1; j < 32; ++j) if (L >= blk[j] * nN) e = j;
        const int r = L - blk[e] * nN;
        const int rb = r / nN; u.pn = r % nN; u.pm = blk[e] + rb; u.aux = e;
        u.nvalid = blk[64 + e] - rb * 256; u.idx = etok + (size_t)e * ECAP + rb * 256;
        u.A = gather ? A : A + (size_t)u.pm * 256 * K; u.B = B + (size_t)e * bstride + (size_t)u.pn * 256 * K; return true;
    }
};

struct EpiMerge {
    static constexpr bool PERM = true, GATHER = false, KHOOK = true; static constexpr int HOOK0 = 8, HOOK1 = 16;
    bf16_t* M; const bf16_t* P;
    __device__ __forceinline__ void khook(f32x4 (&acc)[2][2][4][2], const Unit& u, int kt, int wr, int wc, int fr, int fq) const {
        const int row0 = u.pm * 256 + wr * 64 + fr, col0 = u.pn * 256 + wc * 32 + 8 * fq; const int ja = kt == HOOK0 ? 0 : 1;
        const GAS bf16_t* g = (const GAS bf16_t*)(P + (size_t)row0 * PT + C_GL + ja * D + col0);
#pragma unroll
        for (int ai = 0; ai < 2; ++ai) {
#pragma unroll
            for (int m = 0; m < 4; ++m) {
#pragma unroll
                for (int bj = 0; bj < 2; ++bj) { float sa[8], sb[8]; unpack8(*(const GAS u32x4*)(g + bj * 128), sa); unpack8(*(const GAS u32x4*)(g + D + bj * 128), sb);
#pragma unroll
                    for (int n = 0; n < 2; ++n)
#pragma unroll
                        for (int j = 0; j < 4; ++j) acc[ai][bj][m][n][j] *= sa[4 * n + j] * __builtin_amdgcn_rcpf(sb[4 * n + j]); }
                g += (size_t)16 * PT; asm volatile("" : "+v"(g) :: "memory"); }
            g += (size_t)64 * PT; }
    }
    __device__ __forceinline__ void operator()(const f32x4 (&acc)[2][2][4][2], const Unit& u, int wr, int wc, int fr, int fq) const {
        const int row0 = u.pm * 256 + wr * 64 + fr, col0 = u.pn * 256 + wc * 32 + 8 * fq;
        const GAS bf16_t* g = (const GAS bf16_t*)(P + (size_t)row0 * PT + C_GL + 2 * D + col0); GAS bf16_t* mo = (GAS bf16_t*)(M + (size_t)row0 * D + col0);
#pragma unroll
        for (int ai = 0; ai < 2; ++ai) {
#pragma unroll
            for (int m = 0; m < 4; ++m) {
#pragma unroll
                for (int bj = 0; bj < 2; ++bj) { float s2[8], o[8]; unpack8(*(const GAS u32x4*)(g + bj * 128), s2);
#pragma unroll
                    for (int n = 0; n < 2; ++n)
#pragma unroll
                        for (int j = 0; j < 4; ++j) o[4 * n + j] = acc[ai][bj][m][n][j] * s2[4 * n + j];
                    *(GAS u32x4*)(mo + bj * 128) = pack8(o); }
                g += (size_t)16 * PT; mo += (size_t)16 * D; asm volatile("" : "+v"(g), "+v"(mo) :: "memory"); }
            g += (size_t)64 * PT; mo += (size_t)64 * D; }
    }
};
struct EpiInProj {
    static constexpr bool PERM = true, GATHER = false, KHOOK = false; static constexpr int HOOK0 = -1, HOOK1 = -1;
    bf16_t* P; const float* bias; const f32x2* rope;
    __device__ __forceinline__ void operator()(const f32x4 (&acc)[2][2][4][2], const Unit& u, int wr, int wc, int fr, int fq) const {
        const int row0 = u.pm * 256 + wr * 64 + fr, col0 = u.pn * 256 + wc * 32 + 8 * fq;
        const bool ropet = (u.pn < 4), gate = (u.pn >= 16);
        const bool upper = fq >= 2; const int fi0 = 8 * (fq & 1);
#pragma unroll
        for (int ai = 0; ai < 2; ++ai)
#pragma unroll
            for (int m = 0; m < 4; ++m) {
                const int row = row0 + ai * 128 + m * 16;
                const int s = row & (SEQ - 1); const int pos = (wc & 1) ? (s & 63) : (s >> 6);
                const bool dorope = ropet && (row < NLAT);
#pragma unroll
                for (int bj = 0; bj < 2; ++bj) {
                    float o[8];
#pragma unroll
                    for (int n = 0; n < 2; ++n) { const f32x4 v = acc[ai][bj][m][n] + *(const f32x4*)(bias + col0 + bj * 128 + 4 * n); o[4 * n] = v[0]; o[4 * n + 1] = v[1]; o[4 * n + 2] = v[2]; o[4 * n + 3] = v[3]; }
                    if (gate) {
#pragma unroll
                        for (int j = 0; j < 8; ++j) o[j] = fmaxf(sigmoidf_(o[j]), 1e-20f); }
                    if (ropet) {
#pragma unroll
                        for (int j = 0; j < 8; ++j) { const auto rr = __builtin_amdgcn_permlane32_swap(__float_as_uint(o[j]), __float_as_uint(o[j]), false, false);
                            const float partner = __uint_as_float(upper ? rr[0] : rr[1]); const f32x2 cs = rope[pos * 16 + fi0 + j];
                            const float rot = upper ? (partner * cs.y + o[j] * cs.x) : (o[j] * cs.x - partner * cs.y);
                            o[j] = dorope ? rot : o[j]; } }
                    *(u32x4*)(P + (size_t)row * PT + col0 + bj * 128) = pack8(o);
                }
            }
    }
};
struct EpiWo {
    static constexpr bool PERM = true, GATHER = false, KHOOK = false; static constexpr int HOOK0 = -1, HOOK1 = -1;
    const float* h; const float* hc; bf16_t* V; const float* bo; const float* mod;
    __device__ __forceinline__ void operator()(const f32x4 (&acc)[2][2][4][2], const Unit& u, int wr, int wc, int fr, int fq) const {
        const int row0 = u.pm * 256 + wr * 64 + fr, col0 = u.pn * 256 + wc * 32 + 8 * fq;
#pragma unroll
        for (int ai = 0; ai < 2; ++ai)
#pragma unroll
            for (int m = 0; m < 4; ++m) {
                const int row = row0 + ai * 128 + m * 16; const int r = row < NLAT ? (row >> 12) : 4;
                const float* g1 = mod + r * 6144 + 2 * D;
#pragma unroll
                for (int bj = 0; bj < 2; ++bj) { const int col = col0 + bj * 128; const size_t off = (size_t)row * D + col; float o[8];
#pragma unroll
                    for (int n = 0; n < 2; ++n) { const f32x4 y = acc[ai][bj][m][n] + *(const f32x4*)(bo + col + 4 * n);
                        const f32x4 v = *(const f32x4*)((u.pm < NLAT / 256 ? h : hc) + off + 4 * n) * ALPHA + *(const f32x4*)(g1 + col + 4 * n) * y; o[4 * n] = v[0]; o[4 * n + 1] = v[1]; o[4 * n + 2] = v[2]; o[4 * n + 3] = v[3]; }
                    *(u32x4*)(V + off) = pack8(o); }
            }
    }
};
struct EpiSwiglu {
    static constexpr bool PERM = true, GATHER = true , KHOOK = false; static constexpr int HOOK0 = -1, HOOK1 = -1;
    bf16_t* H; const float* bgu;
    __device__ __forceinline__ void operator()(const f32x4 (&acc)[2][2][4][2], const Unit& u, int wr, int wc, int fr, int fq) const {
        const int row0 = u.pm * 256 + wr * 64 + fr, hc0 = u.pn * 128 + wc * 32 + 8 * fq;
        const float* bg = bgu + u.aux * 2048 + hc0; const float* bu = bg + 1024;
        f32x4 bgv[2], buv[2];
#pragma unroll
        for (int n = 0; n < 2; ++n) { bgv[n] = *(const f32x4*)(bg + 4 * n); buv[n] = *(const f32x4*)(bu + 4 * n); }
#pragma unroll
        for (int ai = 0; ai < 2; ++ai)
#pragma unroll
            for (int m = 0; m < 4; ++m) {
                float o[8];
#pragma unroll
                for (int n = 0; n < 2; ++n) { const f32x4 g = acc[ai][0][m][n] + bgv[n], up = acc[ai][1][m][n] + buv[n];
#pragma unroll
                    for (int j = 0; j < 4; ++j) { const float gg = fminf(g[j], 7.0f), uu = fminf(fmaxf(up[j], -7.0f), 7.0f); o[4 * n + j] = (uu + 1.0f) * gg * sigmoidf_(1.702f * gg); } }
                *(u32x4*)(H + (size_t)(row0 + ai * 128 + m * 16) * D + hc0) = pack8(o);
            }
    }
};
struct EpiDown {
    static constexpr bool PERM = true, GATHER = false, KHOOK = false; static constexpr int HOOK0 = -1, HOOK1 = -1;
    bf16_t* Y; const float* bdn;
    __device__ __forceinline__ void operator()(const f32x4 (&acc)[2][2][4][2], const Unit& u, int wr, int wc, int fr, int fq) const {
        const int row0 = u.pm * 256 + wr * 64 + fr, col0 = u.pn * 256 + wc * 32 + 8 * fq;
        const float* bb = bdn + u.aux * 1024 + col0;
#pragma unroll
        for (int ai = 0; ai < 2; ++ai)
#pragma unroll
            for (int m = 0; m < 4; ++m)
#pragma unroll
                for (int bj = 0; bj < 2; ++bj) { float o[8];
#pragma unroll
                    for (int n = 0; n < 2; ++n) { const f32x4 v = acc[ai][bj][m][n] + *(const f32x4*)(bb + bj * 128 + 4 * n); o[4 * n] = v[0]; o[4 * n + 1] = v[1]; o[4 * n + 2] = v[2]; o[4 * n + 3] = v[3]; }
                    *(u32x4*)(Y + (size_t)(row0 + ai * 128 + m * 16) * D + col0 + bj * 128) = pack8(o); }
    }
};

typedef GAS unsigned gu32;
#define XB_TMO      128
#define XB_XCNT(j)  (256  + 64 * (j))
#define XB_XSUB(j)  (1280 + 64 * (j))
#define XB_XGEN(j)  (2304 + 64 * (j))
#define XB_TOP      3328
#define XB_TOPGEN   3392
#define XCD_BAR_WORDS 3456
#define XB_SPIN_CAP (1u << 18)

__device__ __forceinline__ unsigned xb_ld(unsigned* p)              { return __hip_atomic_load(p, __ATOMIC_RELAXED, __HIP_MEMORY_SCOPE_AGENT); }
__device__ __forceinline__ unsigned xb_add(unsigned* p, unsigned v) { return __hip_atomic_fetch_add(p, v, __ATOMIC_RELAXED, __HIP_MEMORY_SCOPE_AGENT); }
__device__ __forceinline__ unsigned xb_xcc_id() { return (unsigned)__builtin_amdgcn_s_getreg((3 << 11) | 20) & 0xFu; }
#define XB_SPIN(cond, bar) do { unsigned _sp = 0; while (cond) { __builtin_amdgcn_s_sleep(1); \
    if ((++_sp & 255u) == 0u) { if (xb_ld(&(bar)[XB_TMO])) break; if (_sp > XB_SPIN_CAP) { atomicAdd(&(bar)[XB_TMO], 1u); break; } } } } while (0)

struct XcdBarrier {
    unsigned* bar; unsigned x;
    volatile LAS unsigned* st;
};

__device__ __forceinline__ XcdBarrier xcd_barrier_post(unsigned* bar, volatile LAS unsigned* st) {
    XcdBarrier b; b.bar = bar; b.x = xb_xcc_id(); b.st = st;
    if (threadIdx.x == 0) (void)xb_add(&bar[XB_XCNT(b.x)], 1u);
    return b;
}
__device__ __forceinline__ void xcd_barrier_complete(unsigned* bar, unsigned x, unsigned& nloc, unsigned& nx) {
    const unsigned G = gridDim.x * gridDim.y * gridDim.z;
    unsigned sum, cnt, mine, sp = 0u;
    for (;;) {
        sum = 0u; cnt = 0u; mine = 0u;
#pragma unroll
        for (unsigned j = 0; j < 16; ++j) { const unsigned c = xb_ld(&bar[XB_XCNT(j)]); sum += c; cnt += (c > 0u) ? 1u : 0u; mine = (j == x) ? c : mine; }
        if (sum == G) break;
        __builtin_amdgcn_s_sleep(1);
        if ((++sp & 255u) == 0u) { if (xb_ld(&bar[XB_TMO])) break; if (sp > XB_SPIN_CAP) { atomicAdd(&bar[XB_TMO], 1u); break; } }
    }
    nloc = mine > 0u ? mine : 1u; nx = cnt > 0u ? cnt : 1u;
}

__device__ __forceinline__ void xcd_barrier(const XcdBarrier& b) {
    asm volatile("s_waitcnt vmcnt(0)" ::: "memory");
    __syncthreads();
    if (threadIdx.x == 0) {
        unsigned* bar = b.bar;
        __builtin_amdgcn_s_waitcnt(0);
        unsigned nloc = b.st[0], nx = b.st[1];
        if (nloc == 0u) { xcd_barrier_complete(bar, b.x, nloc, nx); b.st[0] = nloc; b.st[1] = nx; }
        const unsigned old = xb_add(&bar[XB_XSUB(b.x)], 1u);
        const unsigned gen = old / nloc;
        if (old + 1u == (gen + 1u) * nloc) {
            __builtin_amdgcn_fence(__ATOMIC_RELEASE, "agent");
            asm volatile("s_waitcnt vmcnt(0)" ::: "memory");
            const unsigned og = xb_add(&bar[XB_TOP], 1u);
            const unsigned tg = og / nx;
            if (og + 1u == (tg + 1u) * nx) xb_add(&bar[XB_TOPGEN], 1u);
            else XB_SPIN(xb_ld(&bar[XB_TOPGEN]) == tg, bar);
            __builtin_amdgcn_fence(__ATOMIC_ACQUIRE, "agent");
            xb_add(&bar[XB_XGEN(b.x)], 1u);
            asm volatile("s_waitcnt vmcnt(0)" ::: "memory");
        } else {
            XB_SPIN(xb_ld(&bar[XB_XGEN(b.x)]) == gen, bar);
            __builtin_amdgcn_fence(__ATOMIC_ACQUIRE, "agent");
            asm volatile("s_waitcnt vmcnt(0)" ::: "memory");
        }
    }
    __syncthreads();
}

typedef const __attribute__((address_space(4))) Params* KP;
struct Ctx {
    KP kp; int tid, lane, wave, bid, nb, gw, ngw; size_t gtid, gthr; LAS unsigned char* lds;
    GAS unsigned char* ws;
};
#define PHASE_BEGIN(C) do { asm volatile("" : "+s"(C.kp)); asm volatile("" : "+s"(C.ws)); asm volatile("" : "+v"(C.tid)); asm volatile("" : "+s"(C.bid)); asm volatile("" : "+s"(C.lds)); \
    C.lane = C.tid & 63; C.wave = __builtin_amdgcn_readfirstlane(C.tid >> 6); C.gw = C.bid * NWAVES + C.wave; C.ngw = C.nb * NWAVES; \
    C.gtid = (size_t)C.bid * NTHR + C.tid; C.gthr = (size_t)C.nb * NTHR; } while (0)
#define PIN_S(x) asm volatile("" : "+s"(x))
#define WSP(T_, off) ((T_*)(GAS T_*)(C.ws + (off)))
#define INP(i) ((const float*)C.kp->in[i])

struct TrFam { const float* W; bf16_t* WT; int nmat, K, N, ldk, koff, gu, first; };
__device__ __forceinline__ void tr_decode(const TrFam& F, int it, const float*& src, bf16_t*& dst, int& d0, int& d1, int& Nn, int& ldk) {
    const int nnb = F.N / 256, per = (F.K / 128) * nnb; const int r0 = it - F.first, mi = r0 / per, r = r0 % per, kb = r / nnb, n0 = (r % nnb) * 256;
    src = F.W + (size_t)mi * F.K * F.N + (size_t)(kb * 128) * F.N + n0; dst = F.WT + (size_t)mi * F.ldk * F.N + F.koff + kb * 128; Nn = F.N; ldk = F.ldk;
    if (F.gu) { const int bj = n0 >> 10, j = n0 & 1023; d0 = 256 * (j >> 7) + 128 * bj; d1 = 256 * ((j + 128) >> 7) + 128 * bj; } else { d0 = n0; d1 = n0 + 128; }
}
__device__ __forceinline__ void phase0_transposes(Ctx& C, int which, int lsel, int bi, int nbk) {
    TrFam F[6]; int tot = 0;
    if (which == 0) {
      const float* srcs[6] = {INP(6), INP(9), INP(10), INP(11), INP(11), INP(20)};
      bf16_t* dsts[6] = {WSP(bf16_t, WS_WIN), WSP(bf16_t, WS_WCAT), WSP(bf16_t, WS_WCAT), WSP(bf16_t, WS_WCAT), WSP(bf16_t, WS_WCAT), WSP(bf16_t, WS_WO)};
      const int Ks[6] = {D, 512, 512, 512, 512, D}, Ns[6] = {PT, D, D, D, D, D}, ld[6] = {D, 2048, 2048, 2048, 2048, D}, ko[6] = {0, 0, 512, 1024, 1536, 0};
#pragma unroll
      for (int f = 0; f < 6; ++f) { F[f].W = srcs[f]; F[f].WT = dsts[f]; F[f].nmat = 2; F[f].K = Ks[f]; F[f].N = Ns[f]; F[f].ldk = ld[f]; F[f].koff = ko[f]; F[f].gu = 0; F[f].first = tot; tot += 2 * (Ks[f] / 128) * (Ns[f] / 256); }
    } else {
      F[0].W = INP(26) + (size_t)lsel * 32 * D * 2048; F[0].WT = WSP(bf16_t, WS_WGU) + (size_t)lsel * 32 * 2048 * D; F[0].nmat = 32; F[0].K = D; F[0].N = 2048; F[0].ldk = D; F[0].koff = 0; F[0].gu = 1; F[0].first = 0; tot = 32 * 8 * 8;
      F[1].W = INP(28) + (size_t)lsel * 32 * D * D; F[1].WT = WSP(bf16_t, WS_WDN) + (size_t)lsel * 32 * D * D; F[1].nmat = 32; F[1].K = D; F[1].N = D; F[1].ldk = D; F[1].koff = 0; F[1].gu = 0; F[1].first = tot; tot += 32 * 8 * 4;
#pragma unroll
      for (int f = 2; f < 6; ++f) { F[f] = F[1]; F[f].first = 0x7fffffff; }
    }
    const int lane = C.lane, w = C.wave;
    f32x4 va[16], vb[16];
    const float* src; bf16_t* dst; int d0, d1, Nn, ldk;
    bf16_t* dstA = nullptr; bf16_t* dstB = nullptr; int d0A = 0, d1A = 0, ldA = 0, d0B = 0, d1B = 0, ldB = 0;
#define TR_FIND(it_) do { int f_ = 0; _Pragma("unroll") for (int q_ = 1; q_ < 6; ++q_) if ((it_) >= F[q_].first) f_ = q_; \
        TrFam G_ = F[0]; _Pragma("unroll") for (int q_ = 1; q_ < 6; ++q_) if (f_ == q_) G_ = F[q_]; tr_decode(G_, (it_), src, dst, d0, d1, Nn, ldk); } while (0)
#define TR_LOAD(v_) do { const float* p_ = src + (size_t)(16 * w) * Nn + 4 * lane; _Pragma("unroll") for (int i = 0; i < 16; ++i) v_[i] = __builtin_nontemporal_load((const f32x4*)(p_ + (size_t)i * Nn)); } while (0)
#define TR_EMIT(v_, dst_, d0_, d1_, ld_, par_) do { LAS unsigned* Tl = (LAS unsigned*)(C.lds + (par_) * 67584); \
        _Pragma("unroll") for (int j = 0; j < 8; ++j) _Pragma("unroll") for (int c = 0; c < 4; ++c) Tl[(4 * lane + c) * 65 + ((8 * w + j) ^ ((lane >> 3) & 3))] = pk2(v_[2 * j][c], v_[2 * j + 1][c]); } while (0)
#define TR_STORE(dst_, d0_, d1_, ld_, par_) do { const LAS unsigned* Tl = (const LAS unsigned*)(C.lds + (par_) * 67584); const int kc = lane & 15, nr = lane >> 4; \
        _Pragma("unroll") for (int q = 0; q < 8; ++q) { const int n = 32 * w + 4 * q + nr; const LAS unsigned* tp = Tl + n * 65 + 4 * kc; \
            const int sw_ = w & 3; u32x4 o; o.x = tp[0 ^ sw_]; o.y = tp[1 ^ sw_]; o.z = tp[2 ^ sw_]; o.w = tp[3 ^ sw_]; const int drow = (n < 128 ? (d0_) : (d1_) - 128) + n; \
            *(u32x4*)((dst_) + (size_t)drow * (ld_) + 8 * kc) = o; } } while (0)
#pragma unroll
    for (int i = 0; i < 16; ++i) { va[i] = (f32x4){0.f, 0.f, 0.f, 0.f}; vb[i] = va[i]; }
    int it = bi;
    if (it < tot) { TR_FIND(it); TR_LOAD(va); dstA = dst; d0A = d0; d1A = d1; ldA = ldk; }
    if (it + nbk < tot) { TR_FIND(it + nbk); TR_LOAD(vb); dstB = dst; d0B = d0; d1B = d1; ldB = ldk; }
    while (it < tot) {
        TR_EMIT(va, dstA, d0A, d1A, ldA, 0);
        bf16_t* cd = dstA; const int c0 = d0A, c1 = d1A, cl = ldA;
        if (it + 2 * nbk < tot) { TR_FIND(it + 2 * nbk); TR_LOAD(va); dstA = dst; d0A = d0; d1A = d1; ldA = ldk; }
        __syncthreads();
        TR_STORE(cd, c0, c1, cl, 0);
        it += nbk; if (it >= tot) break;
        TR_EMIT(vb, dstB, d0B, d1B, ldB, 1);
        cd = dstB; const int e0 = d0B, e1 = d1B, el = ldB;
        if (it + 2 * nbk < tot) { TR_FIND(it + 2 * nbk); TR_LOAD(vb); dstB = dst; d0B = d0; d1B = d1; ldB = ldk; }
        __syncthreads();
        TR_STORE(cd, e0, e1, el, 1);
        it += nbk;
    }
    __syncthreads();
#undef TR_FIND
#undef TR_EMIT
#undef TR_STORE
#undef TR_LOAD
}
__device__ __forceinline__ void phase0(Ctx& C) {
    PHASE_BEGIN(C);

    phase0_transposes(C, 0, 0, C.bid, C.nb);
    { float* mod = WSP(float, WS_MOD); const float* c = INP(1); const float* cc = INP(3); const float* wm = INP(4); const float* bm = INP(5);
      LAS float* red = (LAS float*)(C.lds + 8 * 16384);
      red = (LAS float*)(C.lds + 131072);
      for (int item = C.bid; item < 2 * 192; item += C.nb) {
          const int l = item / 192, j = (item % 192) * 32 + (C.tid & 31), kc = C.tid >> 5;
          float a0 = 0.f, a1 = 0.f, a2 = 0.f, a3 = 0.f, a4 = 0.f;
#pragma unroll 8
          for (int k = kc * 64; k < kc * 64 + 64; ++k) {
              const float w = wm[((size_t)l * D + k) * 6144 + j];
              const float x0 = c[k], x1 = c[D + k], x2 = c[2 * D + k], x3 = c[3 * D + k], x4 = cc[k];
              a0 += x0 * sigmoidf_(x0) * w; a1 += x1 * sigmoidf_(x1) * w; a2 += x2 * sigmoidf_(x2) * w; a3 += x3 * sigmoidf_(x3) * w; a4 += x4 * sigmoidf_(x4) * w;
          }
          __syncthreads();
          red[(0 * 16 + kc) * 32 + (C.tid & 31)] = a0; red[(1 * 16 + kc) * 32 + (C.tid & 31)] = a1; red[(2 * 16 + kc) * 32 + (C.tid & 31)] = a2;
          red[(3 * 16 + kc) * 32 + (C.tid & 31)] = a3; red[(4 * 16 + kc) * 32 + (C.tid & 31)] = a4;
          __syncthreads();
          if (C.tid < 160) { const int r = C.tid >> 5, jj = C.tid & 31; float sacc = bm[l * 6144 + (item % 192) * 32 + jj];
              for (int q = 0; q < 16; ++q) sacc += red[(r * 16 + q) * 32 + jj];
              mod[((size_t)l * 5 + r) * 6144 + (item % 192) * 32 + jj] = sacc; }
      } }
    { f32x2* rope = WSP(f32x2, WS_ROPE);
      for (size_t it = C.gtid; it < 64 * 16; it += C.gthr) { const int pos = (int)(it >> 4), i = (int)(it & 15); const float inv = powf(10000.0f, -(float)i / 16.0f); const float ang = (float)pos * inv; rope[it] = (f32x2){cosf(ang), sinf(ang)}; } }
}
__device__ __forceinline__ void ln_stats(f32x4 (&v)[4], float& mean, float& rstd, int lane) {
    float s = 0.f;
#pragma unroll
    for (int j = 0; j < 4; ++j) s += (v[j].x + v[j].y) + (v[j].z + v[j].w);
    mean = wave_sum(s, lane) * (1.f / D); float s2 = 0.f;
#pragma unroll
    for (int j = 0; j < 4; ++j) { const f32x4 d = v[j] - mean; s2 += (d.x * d.x + d.y * d.y) + (d.z * d.z + d.w * d.w); }
    rstd = __builtin_amdgcn_rsqf(wave_sum(s2, lane) * (1.f / D) + LN_EPS);
}
__device__ __forceinline__ void phase_ln0(Ctx& C, int l) {
    PHASE_BEGIN(C); PIN_S(l);
    const float* hx = INP(0); const float* hcx = INP(2) - (size_t)NLAT * D; bf16_t* U = WSP(bf16_t, WS_U); const float* mod = WSP(float, WS_MOD) + (size_t)l * 5 * 6144;
    for (int row = C.gw; row < T; row += C.ngw) {
        const f32x4* xr = (const f32x4*)((row < NLAT ? hx : hcx) + (size_t)row * D) + C.lane; f32x4 v[4];
#pragma unroll
        for (int j = 0; j < 4; ++j) v[j] = xr[64 * j];
        float mean, rstd; ln_stats(v, mean, rstd, C.lane);
        const int r = row < NLAT ? (row >> 12) : 4; const f32x4* sh = (const f32x4*)(mod + r * 6144) + C.lane; const f32x4* sc = (const f32x4*)(mod + r * 6144 + D) + C.lane;
        u32x2* o = (u32x2*)(U + (size_t)row * D) + C.lane;
#pragma unroll
        for (int j = 0; j < 4; ++j) { const f32x4 y = (v[j] - mean) * rstd * (sc[64 * j] + 1.0f) + sh[64 * j]; u32x2 w; w.x = pk2(y.x, y.y); w.y = pk2(y.z, y.w); o[64 * j] = w; }
    }
}
__device__ __forceinline__ void phase_attn(Ctx& C, int l, bool with_ctx) {
    PHASE_BEGIN(C); PIN_S(l);
    const bf16_t* P = WSP(bf16_t, WS_P); bf16_t* O = WSP(bf16_t, WS_ATT); const float* rpb = INP(8) + (size_t)l * 8 * 15 * 31;
    const size_t nitems = (size_t)(with_ctx ? T : NLAT) * 8;
    for (size_t it = C.gtid; it < nitems; it += C.gthr) {
        const int hd = (int)(it / (with_ctx ? T : NLAT)); const int row = (int)(it % (with_ctx ? T : NLAT));
        const bool lat = row < NLAT; const int b = lat ? (row >> 12) : ((row - NLAT) >> 8);
        float q[64], o[64];
        { const u32x4* qp = (const u32x4*)(P + (size_t)row * PT + C_Q + hd * 64);
#pragma unroll
          for (int j = 0; j < 8; ++j) unpack8(qp[j], q + 8 * j); }
#pragma unroll
        for (int j = 0; j < 64; ++j) { q[j] *= 0.125f; o[j] = 0.f; }
        float mx = -1e30f, lsum = 0.f;
        int r = 0, cc = 0, r0 = 0, cs = 0;
        if (lat) { const int s = row & (SEQ - 1); r = s >> 6; cc = s & 63; r0 = min(max(r - 4, 0), 56); cs = min(max(cc - 8, 0), 48); }
        const int nloc = lat ? 128 : 0;
        for (int kk = 0; kk < nloc + 256; ++kk) {
            int krow; float bias = 0.f;
            if (kk < nloc) { const int i = kk >> 4, j = kk & 15; krow = b * SEQ + (r0 + i) * 64 + cs + j; bias = rpb[(hd * 15 + (r0 + i - r + 7)) * 31 + (cs + j - cc + 15)]; }
            else krow = NLAT + b * CTX + (kk - nloc);
            const u32x4* kp = (const u32x4*)(P + (size_t)krow * PT + C_K + hd * 64);
            float sdot = 0.f;
#pragma unroll
            for (int j = 0; j < 8; ++j) { float kf[8]; unpack8(kp[j], kf);
#pragma unroll
                for (int e = 0; e < 8; ++e) sdot += q[8 * j + e] * kf[e]; }
            sdot += bias;
            const float mn = fmaxf(mx, sdot), f = __expf(mx - mn), pe = __expf(sdot - mn);
            lsum = lsum * f + pe; mx = mn;
            const u32x4* vp = (const u32x4*)(P + (size_t)krow * PT + C_V + hd * 64);
#pragma unroll
            for (int j = 0; j < 8; ++j) { float vf[8]; unpack8(vp[j], vf);
#pragma unroll
                for (int e = 0; e < 8; ++e) o[8 * j + e] = o[8 * j + e] * f + pe * vf[e]; }
        }
        const float inv = 1.0f / lsum;
        u32x4* op = (u32x4*)(O + (size_t)row * 512 + hd * 64);
#pragma unroll
        for (int j = 0; j < 8; ++j) { float t8[8];
#pragma unroll
            for (int e = 0; e < 8; ++e) t8[e] = o[8 * j + e] * inv;
            op[j] = pack8(t8); }
    }
}
typedef float f32x4v __attribute__((ext_vector_type(4)));
typedef unsigned u32x4b __attribute__((ext_vector_type(4)));
template <bool LOCAL>
__device__ __forceinline__ void attn_wave(const bf16_t* P, const bf16_t* VT, bf16_t* O, const LAS float* rp, int lane, int b, int hd, int qrow0, int r, int grp) {
    constexpr int NG = LOCAL ? 16 : 8;
    const int q = lane & 15, g = lane >> 4, i = lane & 15;
    const int r0 = LOCAL ? min(max(r - 4, 0), 56) : 0; const int w0 = LOCAL ? (grp == 0 ? 0 : grp == 1 ? 8 : grp == 2 ? 24 : 32) : 0;
    const __amdgpu_buffer_rsrc_t rP = __builtin_amdgcn_make_buffer_rsrc((void*)P, 0, (int)((size_t)T * PT * 2), 0x00020000);
    const __amdgpu_buffer_rsrc_t rV = __builtin_amdgcn_make_buffer_rsrc((void*)VT, 0, (int)((size_t)512 * T * 2), 0x00020000);
    const int koff = 8 * (i >> 2) + (i & 3);
    const unsigned vK = (unsigned)(koff * PT + 8 * g) * 2u, vV = (unsigned)(i * T + 8 * g) * 2u;
    bf16x8 Qf[2];
#pragma unroll
    for (int ks = 0; ks < 2; ++ks) { float t8[8]; unpack8(*(const u32x4*)(P + (size_t)(qrow0 + q) * PT + C_Q + hd * 64 + 32 * ks + 8 * g), t8);
#pragma unroll
        for (int j = 0; j < 8; ++j) t8[j] *= 0.125f;
        Qf[ks] = __builtin_bit_cast(bf16x8, pack8(t8)); }
#define AT_TOK(s_) ((LOCAL && (s_) < 8) ? (b * SEQ + (r0 + (s_)) * 64 + w0) : (NLAT + b * CTX + 32 * (LOCAL ? (s_) - 8 : (s_))))
#define AT_LDK(dst_, s_) do { const unsigned so_ = (unsigned)(AT_TOK(s_) * PT + C_K + hd * 64) * 2u; \
        dst_[0] = __builtin_amdgcn_raw_buffer_load_b128(rP, vK, so_, 0); dst_[1] = __builtin_amdgcn_raw_buffer_load_b128(rP, vK, so_ + 64u, 0); \
        dst_[2] = __builtin_amdgcn_raw_buffer_load_b128(rP, vK, so_ + 4u * PT * 2u, 0); dst_[3] = __builtin_amdgcn_raw_buffer_load_b128(rP, vK, so_ + 4u * PT * 2u + 64u, 0); } while (0)
#define AT_LDV(dst_, s_) do { const unsigned so_ = (unsigned)((hd * 64) * T + AT_TOK(s_)) * 2u; _Pragma("unroll") for (int dt_ = 0; dt_ < 4; ++dt_) dst_[dt_] = __builtin_amdgcn_raw_buffer_load_b128(rV, vV, so_ + (unsigned)(16 * dt_ * T) * 2u, 0); } while (0)
    f32x4 S[2 * NG];
    u32x4b ring[3][4];
    AT_LDK(ring[0], 0); AT_LDK(ring[1], 1);
#pragma unroll
    for (int s = 0; s < NG; ++s) {
        if (s + 2 < NG) AT_LDK(ring[(s + 2) % 3], s + 2);
#pragma unroll
        for (int tt = 0; tt < 2; ++tt) { f32x4 a = (f32x4){0.f, 0.f, 0.f, 0.f};
            a = __builtin_amdgcn_mfma_f32_16x16x32_bf16(__builtin_bit_cast(bf16x8, ring[s % 3][2 * tt]), Qf[0], a, 0, 0, 0);
            a = __builtin_amdgcn_mfma_f32_16x16x32_bf16(__builtin_bit_cast(bf16x8, ring[s % 3][2 * tt + 1]), Qf[1], a, 0, 0, 0);
            S[2 * s + tt] = a; }
    }
    AT_LDV(ring[0], 0); AT_LDV(ring[1], 1);
    float mx = -1e30f;
    if (LOCAL) {
        const int c = 16 * grp + q, cs = min(max(c - 8, 0), 48);
        const int vb = w0 + 8 * g - cs;
        const LAS float* bp = rp + hd * 465 + (r0 - r + 7) * 31 + (w0 + 8 * g - c + 15);
#pragma unroll
        for (int s = 0; s < 8; ++s)
#pragma unroll
            for (int tt = 0; tt < 2; ++tt)
#pragma unroll
                for (int rg = 0; rg < 4; ++rg) { const bool ok = (unsigned)(vb + rg + 4 * tt) < 16u; const float v = S[2 * s + tt][rg] + bp[s * 31 + rg + 4 * tt];
                    S[2 * s + tt][rg] = ok ? v : -1e30f; }
    }
#pragma unroll
    for (int t = 0; t < 2 * NG; ++t) mx = fmaxf(fmaxf(mx, fmaxf(S[t][0], S[t][1])), fmaxf(S[t][2], S[t][3]));
    mx = fmaxf(mx, bperm(lane ^ 16, mx)); mx = fmaxf(mx, bperm(lane ^ 32, mx));
    float ls = 0.f;
#pragma unroll
    for (int t = 0; t < 2 * NG; ++t)
#pragma unroll
        for (int rg = 0; rg < 4; ++rg) { const float pe = __expf(S[t][rg] - mx); S[t][rg] = pe; ls += pe; }
    ls += bperm(lane ^ 16, ls); ls += bperm(lane ^ 32, ls);
    f32x4 Oa[4];
#pragma unroll
    for (int dt = 0; dt < 4; ++dt) Oa[dt] = (f32x4){0.f, 0.f, 0.f, 0.f};
#pragma unroll
    for (int s = 0; s < NG; ++s) {
        if (s + 2 < NG) AT_LDV(ring[(s + 2) % 3], s + 2);
        float p8[8] = {S[2 * s][0], S[2 * s][1], S[2 * s][2], S[2 * s][3], S[2 * s + 1][0], S[2 * s + 1][1], S[2 * s + 1][2], S[2 * s + 1][3]};
        const bf16x8 pk = __builtin_bit_cast(bf16x8, pack8(p8));
#pragma unroll
        for (int dt = 0; dt < 4; ++dt) Oa[dt] = __builtin_amdgcn_mfma_f32_16x16x32_bf16(__builtin_bit_cast(bf16x8, ring[s % 3][dt]), pk, Oa[dt], 0, 0, 0);
    }
#undef AT_TOK
#undef AT_LDK
#undef AT_LDV
    const float inv = 1.0f / ls;
#pragma unroll
    for (int dt = 0; dt < 4; ++dt) { u32x2 wv; wv.x = pk2(Oa[dt][0] * inv, Oa[dt][1] * inv); wv.y = pk2(Oa[dt][2] * inv, Oa[dt][3] * inv);
        *(u32x2*)(O + (size_t)(qrow0 + q) * 2048 + hd * 64 + 16 * dt + 4 * g) = wv; }
}
__device__ __forceinline__ void phase_attn2(Ctx& C, int l, bool with_ctx, int cslot = 0) {
    PHASE_BEGIN(C); PIN_S(l);
    const bf16_t* P = WSP(bf16_t, WS_P); const bf16_t* VT = WSP(bf16_t, WS_VT); bf16_t* O = WSP(bf16_t, WS_CAT); const float* rpb = INP(8) + (size_t)l * 8 * 465;
    LAS float* rp = (LAS float*)(C.lds + 16384); LAS int* qslot = (LAS int*)(C.lds + 32768);
    __syncthreads();
    for (int t = C.tid; t < 8 * 465; t += NTHR) rp[t] = rpb[t];
    const int xcd = C.bid & 7; int* ctr = WSP(int, WS_CTL) + 128 + cslot * 16 + l * 8 + xcd;
    const int nper = 128 + (with_ctx ? 8 : 0);
    for (;;) {
        __syncthreads();
        if (C.tid == 0) *qslot = atomicAdd(ctr, 1);
        __syncthreads();
        const int j = *qslot; if (j >= nper) break;
        const int w = C.wave;
        if (j < 128) { const int rr = 32 * xcd + (j >> 2), hp = j & 3; const int b = rr >> 6, r = rr & 63, hd = 2 * hp + (w >> 2), grp = w & 3;
            attn_wave<true>(P, VT, O, rp, C.lane, b, hd, b * SEQ + r * 64 + 16 * grp, r, grp); }
        else { const int cidx = xcd * 8 + (j - 128); const int b = cidx >> 4, widx = (cidx & 15) * 8 + w; const int hd = widx >> 4, qg = widx & 15;
            attn_wave<false>(P, VT, O, rp, C.lane, b, hd, NLAT + b * CTX + 16 * qg, 0, 0); }
    }
}
__device__ __forceinline__ bool nb_valid(int row, int d) {
    if (row < NLAT) { const int s = (row & (SEQ - 1)) + d; return s >= 0 && s < SEQ; }
    const int i = ((row - NLAT) & (CTX - 1)) + d; return i >= 0 && i < CTX;
}
__device__ __forceinline__ void conv_chunk(Ctx& C, const bf16_t* P, bf16_t* SC, const float* scw, int chunk) {
#pragma unroll 2
    for (int u = 0; u < 4; ++u) {
        const int it = chunk * 2048 + C.tid + 512 * u; const int row = it >> 6, c0 = (it & 63) * 8;
        float acc[8], sb[8];
#pragma unroll
        for (int e = 0; e < 8; ++e) acc[e] = 0.f;
#pragma unroll
        for (int k = 0; k < 3; ++k) { const int d = k - 1; if (nb_valid(row, d)) { float g[8], x[8]; unpack8(*(const u32x4*)(P + (size_t)(row + d) * PT + C_SCG + c0), g); unpack8(*(const u32x4*)(P + (size_t)(row + d) * PT + C_SX + c0), x);
#pragma unroll
                for (int e = 0; e < 8; ++e) acc[e] += scw[k * 512 + c0 + e] * (g[e] * x[e]); } }
        unpack8(*(const u32x4*)(P + (size_t)row * PT + C_SB + c0), sb);
#pragma unroll
        for (int e = 0; e < 8; ++e) acc[e] *= sb[e];
        *(u32x4*)(SC + (size_t)row * 2048 + c0) = pack8(acc);
    }
}
constexpr int A3_CK = 0, A3_CV = 32768, A3_LK = 66560, A3_RP = 133120, A3_MG = 135168, A3_QS = 152064, A3_CVS = 528, A3_LVS = 1040;
__device__ __forceinline__ int a3_f(int kk) { return (((kk >> 3) & 3) << 1) | ((kk >> 1) & 1); }
template <bool LOCAL>
__device__ __forceinline__ void attn_item(Ctx& C, const bf16_t* P, const bf16_t* VT, bf16_t* O, const float* rpb_l, int b, int hd, int r, int qrow_base) {
    const int tid = C.tid, lane = C.lane, w = C.wave, grp = w & 3, kh = w >> 2;
    const int q = lane & 15, g = lane >> 4, i = lane & 15;
    const int r0 = LOCAL ? min(max(r - 4, 0), 56) : 0; const int w0 = LOCAL ? (grp == 0 ? 0 : grp == 1 ? 8 : grp == 2 ? 24 : 32) : 0;
    LAS unsigned char* L = C.lds;
    constexpr int NA = LOCAL ? 12 : 4;
    u32x4 st[NA];
#pragma unroll
    for (int u = 0; u < 4; ++u) { const int p = tid + 512 * u, k = p >> 3, c = (p & 7) ^ a3_f(k); st[u] = *(const u32x4*)(P + (size_t)(NLAT + b * CTX + k) * PT + C_K + hd * 64 + 8 * c); }
    if (LOCAL) {
#pragma unroll
        for (int u = 0; u < 8; ++u) { const int p = tid + 512 * u, kk = p >> 3, c = (p & 7) ^ a3_f(kk); const int row = b * SEQ + (r0 + (kk >> 6)) * 64 + (kk & 63);
            st[4 + u] = *(const u32x4*)(P + (size_t)row * PT + C_K + hd * 64 + 8 * c); } }
    float rpv = 0.f; if (LOCAL && tid < 465) rpv = rpb_l[hd * 465 + tid];
    const int qrow0 = qrow_base + 16 * grp;
    bf16x8 Qf[2];
#pragma unroll
    for (int ks = 0; ks < 2; ++ks) { float t8[8]; unpack8(*(const u32x4*)(P + (size_t)(qrow0 + q) * PT + C_Q + hd * 64 + 32 * ks + 8 * g), t8);
#pragma unroll
        for (int j = 0; j < 8; ++j) t8[j] *= 0.125f;
        Qf[ks] = __builtin_bit_cast(bf16x8, pack8(t8)); }
#pragma unroll
    for (int u = 0; u < 4; ++u) *(LAS u32x4*)(L + A3_CK + (tid + 512 * u) * 16) = st[u];
    if (LOCAL) {
#pragma unroll
        for (int u = 0; u < 8; ++u) *(LAS u32x4*)(L + A3_LK + (tid + 512 * u) * 16) = st[4 + u];
        if (tid < 465) ((LAS float*)(L + A3_RP))[tid] = rpv; }
    __syncthreads();
#pragma unroll
    for (int u = 0; u < 4; ++u) { const int p = tid + 512 * u, dh = p >> 5, ch = p & 31; st[u] = *(const u32x4*)(VT + (size_t)(hd * 64 + dh) * T + NLAT + b * CTX + 8 * ch); }
    if (LOCAL) {
#pragma unroll
        for (int u = 0; u < 8; ++u) { const int p = tid + 512 * u, dh = p >> 6, ch = p & 63; const int tok = b * SEQ + (r0 + (ch >> 3)) * 64 + 8 * (ch & 7);
            st[4 + u] = *(const u32x4*)(VT + (size_t)(hd * 64 + dh) * T + tok); } }
    constexpr int NT = LOCAL ? 16 : 8;
    f32x4 S[NT];
    const int koff = 8 * (i >> 2) + (i & 3);
#pragma unroll
    for (int j = 0; j < 4; ++j)
#pragma unroll
        for (int tt = 0; tt < 2; ++tt) { const int kk = 128 * kh + 32 * j + koff + 4 * tt, fs = a3_f(kk); const LAS unsigned char* kb = L + A3_CK + kk * 128;
            f32x4 a = (f32x4){0.f, 0.f, 0.f, 0.f};
            a = __builtin_amdgcn_mfma_f32_16x16x32_bf16(*(const LAS bf16x8*)(kb + ((g ^ fs) << 4)), Qf[0], a, 0, 0, 0);
            a = __builtin_amdgcn_mfma_f32_16x16x32_bf16(*(const LAS bf16x8*)(kb + (((g + 4) ^ fs) << 4)), Qf[1], a, 0, 0, 0);
            S[2 * j + tt] = a; }
    if (LOCAL) {
#pragma unroll
        for (int j = 0; j < 4; ++j)
#pragma unroll
            for (int tt = 0; tt < 2; ++tt) { const int kk = (4 * kh + j) * 64 + w0 + koff + 4 * tt, fs = a3_f(kk); const LAS unsigned char* kb = L + A3_LK + kk * 128;
                f32x4 a = (f32x4){0.f, 0.f, 0.f, 0.f};
                a = __builtin_amdgcn_mfma_f32_16x16x32_bf16(*(const LAS bf16x8*)(kb + ((g ^ fs) << 4)), Qf[0], a, 0, 0, 0);
                a = __builtin_amdgcn_mfma_f32_16x16x32_bf16(*(const LAS bf16x8*)(kb + (((g + 4) ^ fs) << 4)), Qf[1], a, 0, 0, 0);
                S[8 + 2 * j + tt] = a; }
        const int c = 16 * grp + q, cs = min(max(c - 8, 0), 48);
        const int vb = w0 + 8 * g - cs;
        const LAS float* bp = (const LAS float*)(L + A3_RP) + (r0 - r + 7 + 4 * kh) * 31 + (w0 + 8 * g - c + 15);
#pragma unroll
        for (int j = 0; j < 4; ++j)
#pragma unroll
            for (int tt = 0; tt < 2; ++tt)
#pragma unroll
                for (int rg = 0; rg < 4; ++rg) { const bool ok = (unsigned)(vb + rg + 4 * tt) < 16u; const float v = S[8 + 2 * j + tt][rg] + bp[j * 31 + rg + 4 * tt];
                    S[8 + 2 * j + tt][rg] = ok ? v : -1e30f; }
    }
    float mx = -1e30f;
#pragma unroll
    for (int t = 0; t < NT; ++t) mx = fmaxf(fmaxf(mx, fmaxf(S[t][0], S[t][1])), fmaxf(S[t][2], S[t][3]));
    mx = fmaxf(mx, bperm(lane ^ 16, mx)); mx = fmaxf(mx, bperm(lane ^ 32, mx));
    float ls = 0.f;
#pragma unroll
    for (int t = 0; t < NT; ++t)
#pragma unroll
        for (int rg = 0; rg < 4; ++rg) { const float pe = __expf(S[t][rg] - mx); S[t][rg] = pe; ls += pe; }
    ls += bperm(lane ^ 16, ls); ls += bperm(lane ^ 32, ls);
    __syncthreads();
#pragma unroll
    for (int u = 0; u < 4; ++u) { const int p = tid + 512 * u; *(LAS u32x4*)(L + A3_CV + (p >> 5) * A3_CVS + (p & 31) * 16) = st[u]; }
    if (LOCAL) {
#pragma unroll
        for (int u = 0; u < 8; ++u) { const int p = tid + 512 * u; *(LAS u32x4*)(L + A3_LK + (p >> 6) * A3_LVS + (p & 63) * 16) = st[4 + u]; } }
    __syncthreads();
    f32x4 Oa[4];
#pragma unroll
    for (int dt = 0; dt < 4; ++dt) Oa[dt] = (f32x4){0.f, 0.f, 0.f, 0.f};
#pragma unroll
    for (int j = 0; j < 4; ++j) {
        float p8[8] = {S[2 * j][0], S[2 * j][1], S[2 * j][2], S[2 * j][3], S[2 * j + 1][0], S[2 * j + 1][1], S[2 * j + 1][2], S[2 * j + 1][3]};
        const bf16x8 pk = __builtin_bit_cast(bf16x8, pack8(p8));
#pragma unroll
        for (int dt = 0; dt < 4; ++dt) Oa[dt] = __builtin_amdgcn_mfma_f32_16x16x32_bf16(*(const LAS bf16x8*)(L + A3_CV + (16 * dt + i) * A3_CVS + (128 * kh + 32 * j + 8 * g) * 2), pk, Oa[dt], 0, 0, 0);
    }
    if (LOCAL) {
#pragma unroll
        for (int j = 0; j < 4; ++j) {
            float p8[8] = {S[8 + 2 * j][0], S[8 + 2 * j][1], S[8 + 2 * j][2], S[8 + 2 * j][3], S[9 + 2 * j][0], S[9 + 2 * j][1], S[9 + 2 * j][2], S[9 + 2 * j][3]};
            const bf16x8 pk = __builtin_bit_cast(bf16x8, pack8(p8));
#pragma unroll
            for (int dt = 0; dt < 4; ++dt) Oa[dt] = __builtin_amdgcn_mfma_f32_16x16x32_bf16(*(const LAS bf16x8*)(L + A3_LK + (16 * dt + i) * A3_LVS + ((4 * kh + j) * 64 + w0 + 8 * g) * 2), pk, Oa[dt], 0, 0, 0);
        }
    }
    LAS unsigned char* MG = L + A3_MG + grp * 4224;
    if (kh == 1) {
#pragma unroll
        for (int dt = 0; dt < 4; ++dt) *(LAS f32x4*)(MG + (q * 64 + 16 * dt + 4 * g) * 4) = Oa[dt];
        if (g == 0) { ((LAS float*)(MG + 4096))[2 * q] = mx; ((LAS float*)(MG + 4096))[2 * q + 1] = ls; } }
    __syncthreads();
    if (kh == 0) {
        const float m1 = ((const LAS float*)(MG + 4096))[2 * q], l1 = ((const LAS float*)(MG + 4096))[2 * q + 1];
        const float m = fmaxf(mx, m1), f0 = __expf(mx - m), f1 = __expf(m1 - m); const float inv = 1.0f / (ls * f0 + l1 * f1);
#pragma unroll
        for (int dt = 0; dt < 4; ++dt) { const f32x4 o1 = *(const LAS f32x4*)(MG + (q * 64 + 16 * dt + 4 * g) * 4); const f32x4 o = (Oa[dt] * f0 + o1 * f1) * inv;
            u32x2 wv; wv.x = pk2(o[0], o[1]); wv.y = pk2(o[2], o[3]);
            *(u32x2*)(O + (size_t)(qrow0 + q) * 2048 + hd * 64 + 16 * dt + 4 * g) = wv; } }
}
__device__ __forceinline__ void phase_attn3(Ctx& C, int l, bool with_ctx, int cslot = 0) {
    PHASE_BEGIN(C); PIN_S(l);
    const bf16_t* P = WSP(bf16_t, WS_P); const bf16_t* VT = WSP(bf16_t, WS_VT); bf16_t* O = WSP(bf16_t, WS_CAT); const float* rpb = INP(8) + (size_t)l * 8 * 465;
    LAS int* qslot = (LAS int*)(C.lds + A3_QS);
    const int xcd = C.bid & 7; int* ctr = WSP(int, WS_CTL) + 128 + cslot * 16 + l * 8 + xcd;
    const int nper = 256 + (with_ctx ? 16 : 0);
    const int nconv = ((l == 1 ? NLAT : T) / 32) / 8;
    bf16_t* SC = WSP(bf16_t, WS_CAT) + 512; const float* scw = INP(12) + (size_t)l * 3 * 512;
    for (;;) {
        __syncthreads();
        if (C.tid == 0) *qslot = atomicAdd(ctr, 1);
        __syncthreads();
        const int j = *qslot; if (j >= nper + nconv) break;
        if (j >= nper) { conv_chunk(C, P, SC, scw, (j - nper) * 8 + xcd); continue; }
        if (j < 256) { const int rr = 32 * xcd + (j >> 3), hd = j & 7; const int b = rr >> 6, r = rr & 63;
            attn_item<true>(C, P, VT, O, rpb, b, hd, r, b * SEQ + r * 64); }
        else { const int cidx = 16 * xcd + (j - 256); const int b = cidx >> 5, hd = (cidx >> 2) & 7, ch = cidx & 3;
            attn_item<false>(C, P, VT, O, rpb, b, hd, 0, NLAT + b * CTX + 64 * ch); }
    }
}
typedef float f32x16 __attribute__((ext_vector_type(16)));
__device__ __forceinline__ int lru_row(int b, int d, int p) {
    if (p < CTX) return NLAT + b * CTX + (d ? CTX - 1 - p : p);
    const int s = p - CTX; return b * SEQ + (d ? SEQ - 1 - s : s);
}
__device__ __forceinline__ float fsigmoid(float x) { return __builtin_amdgcn_rcpf(1.0f + __expf(-x)); }
__device__ __forceinline__ void phase_lru(Ctx& C, int l) {
    PHASE_BEGIN(C); PIN_S(l);
    const bf16_t* P = WSP(bf16_t, WS_P); bf16_t* LR = WSP(bf16_t, WS_CAT) + 1024;
    const float* lcw = INP(13) + (size_t)l * 4 * 512; const float* lcb = INP(14) + (size_t)l * 512; const float* lam = INP(15) + (size_t)l * 2 * 512;
    const float* wr_ = INP(16) + (size_t)l * 2 * 8 * 4096; const float* br = INP(17) + (size_t)l * 2 * 512;
    const float* wi_ = INP(18) + (size_t)l * 2 * 8 * 4096; const float* bi = INP(19) + (size_t)l * 2 * 512;
    LAS float* cw = (LAS float*)C.lds;
    LAS f32x2* agg = (LAS f32x2*)(C.lds + 2048);
    const int lane = C.lane, w = C.wave, col = lane & 31, hi = lane >> 5;
    LAS unsigned char* Llx = C.lds + 8192 + w * 10240; LAS unsigned char* Llg = Llx + 5120; LAS unsigned char* Lout = Llx + 7680;
    for (int item = C.bid; item < 128; item += C.nb) {
        const int b = item >> 5, d = (item >> 4) & 1, n = (item >> 1) & 7, half = item & 1;
        __syncthreads();
        if (C.tid < 320) cw[C.tid] = C.tid < 256 ? lcw[(C.tid >> 6) * 512 + n * 64 + (C.tid & 63)] : lcb[n * 64 + (C.tid - 256)];
        __syncthreads();
        const int e = n * 64 + half * 32 + col;
        bf16x8 Br[4], Bi[4], Bid[2];
#pragma unroll
        for (int ks = 0; ks < 4; ++ks) { float vr[8], vi[8];
#pragma unroll
            for (int j = 0; j < 8; ++j) { const size_t o = ((size_t)(d * 8 + n) * 64 + 16 * ks + 8 * hi + j) * 64 + half * 32 + col; vr[j] = wr_[o]; vi[j] = wi_[o]; }
            Br[ks] = __builtin_bit_cast(bf16x8, pack8(vr)); Bi[ks] = __builtin_bit_cast(bf16x8, pack8(vi)); }
#pragma unroll
        for (int q = 0; q < 2; ++q) { float v1[8];
#pragma unroll
            for (int j = 0; j < 8; ++j) v1[j] = (16 * q + 8 * hi + j == col) ? 1.0f : 0.0f;
            Bid[q] = __builtin_bit_cast(bf16x8, pack8(v1)); }
        const float cl2 = -8.0f * log1pf(expf(-lam[d * 512 + e])) * 1.4426950408889634f;
        const float brv = br[d * 512 + e], biv = bi[d * 512 + e];
#define LRU_RLO(sc_) ((sc_) == 0 ? NLAT + b * CTX + (d ? 224 - w * 32 : w * 32) : b * SEQ + (d ? 4064 - (((sc_) - 1) * 256 + w * 32) : ((sc_) - 1) * 256 + w * 32))
#define LRU_LOAD(sc_) do { const int rlo_ = LRU_RLO(sc_); const int slo_ = (sc_) == 0 ? NLAT + b * CTX : b * SEQ, shi_ = (sc_) == 0 ? slo_ + CTX : slo_ + SEQ; \
        _Pragma("unroll") for (int u = 0; u < 5; ++u) { const int q_ = lane + 64 * u; const int t_ = q_ >> 3; const int row_ = rlo_ - 2 + t_; const bool ok_ = (q_ < 280) && row_ >= slo_ && row_ < shi_; \
            const int rc_ = ok_ ? row_ : rlo_; const u32x4 v_ = *(const u32x4*)(P + (size_t)rc_ * PT + C_LX + n * 64 + 8 * (q_ & 7)); lxr[u] = ok_ ? v_ : (u32x4){0u, 0u, 0u, 0u}; } \
        _Pragma("unroll") for (int u = 0; u < 2; ++u) { const int q_ = lane + 64 * u; lgr[u] = *(const u32x4*)(P + (size_t)(rlo_ + (q_ >> 2)) * PT + C_LG + n * 64 + half * 32 + 8 * (q_ & 3)); } } while (0)
        u32x4 lxr[5], lgr[2];
        LRU_LOAD(0);
        float run = 0.f;
#pragma unroll 1
        for (int sc = 0; sc < 17; ++sc) {
            const int rlo = LRU_RLO(sc);
#pragma unroll
            for (int u = 0; u < 5; ++u) { const int q_ = lane + 64 * u; if (q_ < 280) *(LAS u32x4*)(Llx + (q_ >> 3) * 144 + (q_ & 7) * 16) = lxr[u]; }
#pragma unroll
            for (int u = 0; u < 2; ++u) { const int q_ = lane + 64 * u; *(LAS u32x4*)(Llg + (q_ >> 2) * 80 + (q_ & 3) * 16) = lgr[u]; }
            if (sc + 1 < 17) LRU_LOAD(sc + 1);
            const int pa = 16 * ((col >> 2) & 1) + 4 * (col >> 3) + (col & 3);
            const int rho = d ? 31 - pa : pa;
            bf16x8 A[4];
#pragma unroll
            for (int ks = 0; ks < 4; ++ks) { const int k0 = 16 * ks + 8 * hi; float x[8];
#pragma unroll
                for (int j = 0; j < 8; ++j) x[j] = cw[256 + k0 + j];
#pragma unroll
                for (int tap = 0; tap < 4; ++tap) { float v8[8]; unpack8(*(const LAS u32x4*)(Llx + (rho + tap) * 144 + (2 * ks + hi) * 16), v8);
#pragma unroll
                    for (int j = 0; j < 8; ++j) x[j] += cw[tap * 64 + k0 + j] * v8[j]; }
                A[ks] = __builtin_bit_cast(bf16x8, pack8(x)); }
            f32x16 aR, aI, aX;
#pragma unroll
            for (int r = 0; r < 16; ++r) { aR[r] = brv; aI[r] = biv; aX[r] = 0.f; }
#pragma unroll
            for (int ks = 0; ks < 4; ++ks) { aR = __builtin_amdgcn_mfma_f32_32x32x16_bf16(A[ks], Br[ks], aR, 0, 0, 0); aI = __builtin_amdgcn_mfma_f32_32x32x16_bf16(A[ks], Bi[ks], aI, 0, 0, 0); }
            { const bf16x8 Ax0 = half ? A[2] : A[0], Ax1 = half ? A[3] : A[1];
              aX = __builtin_amdgcn_mfma_f32_32x32x16_bf16(Ax0, Bid[0], aX, 0, 0, 0); aX = __builtin_amdgcn_mfma_f32_32x32x16_bf16(Ax1, Bid[1], aX, 0, 0, 0); }
            float hl[16], ac[16]; float h = 0.f, Ac = 1.f;
#pragma unroll
            for (int r = 0; r < 16; ++r) {
                const float rr = fsigmoid(aR[r]), ig = fsigmoid(aI[r]); const float la2 = cl2 * rr; const float a = __builtin_amdgcn_exp2f(la2);
                const float x2 = la2 * 1.3862943611198906f;
                const float poly = -x2 * (1.0f + x2 * (0.5f + x2 * (0.16666667f + x2 * (0.041666668f + x2 * (0.0083333338f + x2 * 0.0013888889f)))));
                const float em = x2 > -0.3f ? poly : 1.0f - a * a;
                const float bb = __builtin_amdgcn_sqrtf(em) * (ig * aX[r]);
                h = a * h + bb; Ac *= a; hl[r] = h; ac[r] = Ac;
            }
            const float A0 = bperm(col, Ac), h0 = bperm(col, h), A1 = bperm(col + 32, Ac), h1 = bperm(col + 32, h);
            const int par = sc & 1;
            if (hi == 0) agg[(par * 8 + w) * 32 + col] = (f32x2){A0 * A1, h1 + A1 * h0};
            __syncthreads();
            float carry = run, cin = 0.f;
#pragma unroll
            for (int ww = 0; ww < 8; ++ww) { const f32x2 g = agg[(par * 8 + ww) * 32 + col]; if (ww == w) cin = carry; carry = g.y + g.x * carry; }
            run = carry;
            const float cl = hi ? (h0 + A0 * cin) : cin;
#pragma unroll
            for (int r = 0; r < 16; ++r) { const int rr_ = d ? 31 - (16 * hi + r) : 16 * hi + r;
                const float lgv = bf2f(*(const LAS unsigned short*)(Llg + rr_ * 80 + col * 2)); const float hf = hl[r] + ac[r] * cl;
                const float u = 0.7978845608028654f * (lgv + 0.044715f * lgv * lgv * lgv);
                *(LAS unsigned short*)(Lout + rr_ * 80 + col * 2) = (unsigned short)f2bf(lgv * fsigmoid(2.0f * u) * hf); }
#pragma unroll
            for (int u = 0; u < 2; ++u) { const int q_ = lane + 64 * u; const u32x4 o = *(const LAS u32x4*)(Lout + (q_ >> 2) * 80 + (q_ & 3) * 16);
                *(u32x4*)(LR + (size_t)(rlo + (q_ >> 2)) * 2048 + d * 512 + n * 64 + half * 32 + 8 * (q_ & 3)) = o; }
        }
#undef LRU_RLO
#undef LRU_LOAD
    }
}
__device__ __forceinline__ void phase_ln1(Ctx& C, int l, int nrows, bool probe = false) {
    PHASE_BEGIN(C); PIN_S(l);
    const bf16_t* V = WSP(bf16_t, WS_V); float* H = WSP(float, WS_H); bf16_t* U = WSP(bf16_t, WS_U); const float* mod = WSP(float, WS_MOD) + (size_t)l * 5 * 6144;
    const float* g1 = INP(22) + l * D; const float* b1 = INP(23) + l * D; const float* rw = INP(24) + (size_t)l * D * 32; const float* rb = INP(25) + l * 32;
    int* topi = WSP(int, WS_SMALL); float* topp = WSP(float, WS_SMALL + 512 * 1024); int* cnt = WSP(int, WS_CTL) + 1024 + l * 1024;
    int* epos = WSP(int, WS_SMALL + 1 * MiB); int* etok = WSP(int, WS_ETOK) + (size_t)l * 32 * ECAP;
    if (probe) { topi = WSP(int, WS_RA); topp = WSP(float, WS_RA + 1 * MiB); epos = WSP(int, WS_RA + 2 * MiB); etok = WSP(int, WS_RA + 4 * MiB); cnt = WSP(int, WS_CTL) + 8192 + l * 1024; }
    LAS float* Ut = (LAS float*)C.lds;
    LAS float* Pt = (LAS float*)(C.lds + 65792);
    LAS float* Lg = (LAS float*)(C.lds + 65792 + 16384);
    LAS int* lcnt = (LAS int*)(C.lds + LDS_LN1); LAS int* lbase = lcnt + 32; LAS int* rec = lcnt + 64;
    __syncthreads();
    if (C.tid < 32) lcnt[C.tid] = 0;
    const int lane = C.lane, w = C.wave, e = lane & 31, hr = lane >> 5;
    float Bf[32][2];
#pragma unroll
    for (int s_ = 0; s_ < 32; ++s_)
#pragma unroll
        for (int t = 0; t < 2; ++t) Bf[s_][t] = rw[(size_t)(128 * w + 4 * s_ + (lane >> 4)) * 32 + 16 * t + (lane & 15)];
    const float rbe = rb[e];
    const int nbatch = nrows / 16;
    f32x4 vn[2][4];
#define LN1_LOADV(q_, row_) do { _Pragma("unroll") for (int j = 0; j < 4; ++j) { const u32x2 w_ = ((const u32x2*)(V + (size_t)(row_) * D) + lane)[64 * j]; \
        vn[q_][j] = (f32x4){bf2f(w_.x & 0xffffu), bf2f(w_.x >> 16), bf2f(w_.y & 0xffffu), bf2f(w_.y >> 16)}; } } while (0)
#pragma unroll
    for (int q = 0; q < 2; ++q)
#pragma unroll
        for (int j = 0; j < 4; ++j) vn[q][j] = (f32x4){0.f, 0.f, 0.f, 0.f};
    int bt = C.bid, ri = 0;
    if (bt < nbatch) { LN1_LOADV(0, bt * 16 + 2 * w); LN1_LOADV(1, bt * 16 + 2 * w + 1); }
    while (bt < nbatch) {
        const int nbt = bt + C.nb;
#pragma unroll
        for (int q = 0; q < 2; ++q) {
            const int row = bt * 16 + 2 * w + q;
            f32x4 v[4];
#pragma unroll
            for (int j = 0; j < 4; ++j) v[j] = vn[q][j];
            if (nbt < nbatch) { LN1_LOADV(q, nbt * 16 + 2 * w + q); }
            float mean, rstd; ln_stats(v, mean, rstd, lane);
            f32x4* ho = (f32x4*)(H + (size_t)row * D) + lane;
#pragma unroll
            for (int j = 0; j < 4; ++j) { v[j] = (v[j] - mean) * rstd * ((const f32x4*)g1)[lane + 64 * j] + ((const f32x4*)b1)[lane + 64 * j]; ho[64 * j] = v[j]; }
            ln_stats(v, mean, rstd, lane);
            const int r = row < NLAT ? (row >> 12) : 4; const f32x4* sh = (const f32x4*)(mod + r * 6144 + 3 * D) + lane; const f32x4* sc = (const f32x4*)(mod + r * 6144 + 4 * D) + lane;
            u32x2* o = (u32x2*)(U + (size_t)row * D) + lane;
#pragma unroll
            for (int j = 0; j < 4; ++j) { v[j] = (v[j] - mean) * rstd * (sc[64 * j] + 1.0f) + sh[64 * j]; u32x2 wv; wv.x = pk2(v[j].x, v[j].y); wv.y = pk2(v[j].z, v[j].w); o[64 * j] = wv;
                *(LAS f32x4*)(Ut + (2 * w + q) * 1028 + 4 * lane + 256 * j) = v[j]; }
        }
        __syncthreads();
        { f32x4 a0 = (f32x4){0.f, 0.f, 0.f, 0.f}, a1 = a0;
          const LAS float* ap = Ut + (lane & 15) * 1028 + 128 * w + (lane >> 4);
#pragma unroll
          for (int s_ = 0; s_ < 32; ++s_) { const float av = ap[4 * s_];
              a0 = __builtin_amdgcn_mfma_f32_16x16x4f32(av, Bf[s_][0], a0, 0, 0, 0); a1 = __builtin_amdgcn_mfma_f32_16x16x4f32(av, Bf[s_][1], a1, 0, 0, 0); }
          LAS float* pp = Pt + (w * 16 + 4 * (lane >> 4)) * 32 + (lane & 15);
#pragma unroll
          for (int rg = 0; rg < 4; ++rg) { pp[rg * 32] = a0[rg]; pp[rg * 32 + 16] = a1[rg]; } }
        __syncthreads();
        { const int q = 2 * w + hr, row = bt * 16 + q;
          float acc = rbe;
#pragma unroll
          for (int ww = 0; ww < 8; ++ww) acc += Pt[(ww * 16 + q) * 32 + e];
          Lg[q * 32 + e] = acc;
          asm volatile("s_waitcnt lgkmcnt(0)" ::: "memory");
          int rank = 0;
#pragma unroll
          for (int g = 0; g < 8; ++g) { const f32x4 lq = *(const LAS f32x4*)(Lg + q * 32 + 4 * g);
#pragma unroll
              for (int j = 0; j < 4; ++j) rank += (lq[j] > acc || (lq[j] == acc && 4 * g + j < e)) ? 1 : 0; }
          const bool sel = rank < 4;
          const float t0c = (rank == 0) ? acc : -3.0e38f;
          float t0 = t0c;
#pragma unroll
          for (int o_ = 1; o_ < 32; o_ <<= 1) t0 = fmaxf(t0, bperm(lane ^ o_, t0));
          const float pe = sel ? __expf(acc - t0) : 0.f;
          float psum = pe;
#pragma unroll
          for (int o_ = 1; o_ < 32; o_ <<= 1) psum += bperm(lane ^ o_, psum);
          if (sel) {
              topi[(size_t)row * 4 + rank] = e; topp[(size_t)row * 4 + rank] = pe * __builtin_amdgcn_rcpf(psum);
              const int lpos = __hip_atomic_fetch_add(lcnt + e, 1, __ATOMIC_RELAXED, __HIP_MEMORY_SCOPE_WORKGROUP);
              rec[((w * 2 + hr) * 8 + ri) * 4 + rank] = (e << 16) | lpos;
          } }
        ++ri; bt = nbt;
    }
#undef LN1_LOADV
    __syncthreads();
    if (C.tid < 32) lbase[C.tid] = atomicAdd(cnt + 32 * C.tid, lcnt[C.tid]);
    __syncthreads();
    if ((lane & 31) < 4) { const int k = lane & 31; int bt2 = C.bid;
        for (int i = 0; i < ri; ++i, bt2 += C.nb) { const int row = bt2 * 16 + 2 * w + hr; const int rr = rec[((w * 2 + hr) * 8 + i) * 4 + k]; const int ek = rr >> 16, pos = lbase[ek] + (rr & 0xffff);
            etok[(size_t)ek * ECAP + pos] = row; epos[(size_t)row * 4 + k] = pos; } }
}
__device__ __forceinline__ void build_blk(Ctx& C, int l) {
    LAS int* blk = (LAS int*)(C.lds + 131072); LAS int* cl = blk + 64; LAS int* nbk = blk + 128; const int* cnt = WSP(int, WS_CTL) + 1024 + l * 1024;
    __syncthreads();
    if (C.tid < 32) { const int c = __hip_atomic_load(cnt + 32 * C.tid, __ATOMIC_RELAXED, __HIP_MEMORY_SCOPE_AGENT); cl[C.tid] = c; nbk[C.tid] = (c + 255) >> 8; }
    __syncthreads();
    if (C.tid < 33) { int s_ = 0; for (int e = 0; e < C.tid; ++e) s_ += nbk[e]; blk[C.tid] = s_; }
    __syncthreads();
}
__device__ __forceinline__ void phase_combine(Ctx& C, int l, int nrows, bool last, bool probe = false) {
    PHASE_BEGIN(C); PIN_S(l);
    bf16_t* U = WSP(bf16_t, WS_U); const float* modn = WSP(float, WS_MOD) + (size_t)(l + 1) * 5 * 6144;
    float* H = WSP(float, WS_H); const bf16_t* Y = WSP(bf16_t, WS_RA); const float* mod = WSP(float, WS_MOD) + (size_t)l * 5 * 6144;
    const float* g2 = INP(30) + l * D; const float* b2 = INP(31) + l * D; const float* topp = WSP(float, WS_SMALL + 512 * 1024); const int* epos = WSP(int, WS_SMALL + 1 * MiB); const int* topi = WSP(int, WS_SMALL);
    build_blk(C, l); const LAS int* blk = (const LAS int*)(C.lds + 131072);
#define CMB_IDX(row_, sl_, te_, pp_) do { sl_ = *(const int4*)(epos + (size_t)(row_) * 4); te_ = *(const int4*)(topi + (size_t)(row_) * 4); pp_ = *(const f32x4*)(topp + (size_t)(row_) * 4); } while (0)
#define CMB_DATA(row_, sl_, te_, yd_, hd_) do { const int s0_ = blk[te_.x] * 256 + sl_.x, s1_ = blk[te_.y] * 256 + sl_.y, s2_ = blk[te_.z] * 256 + sl_.z, s3_ = blk[te_.w] * 256 + sl_.w; \
        _Pragma("unroll") for (int j = 0; j < 4; ++j) { yd_[0][j] = ((const u32x2*)(Y + (size_t)s0_ * D) + C.lane)[64 * j]; yd_[1][j] = ((const u32x2*)(Y + (size_t)s1_ * D) + C.lane)[64 * j]; \
            yd_[2][j] = ((const u32x2*)(Y + (size_t)s2_ * D) + C.lane)[64 * j]; yd_[3][j] = ((const u32x2*)(Y + (size_t)s3_ * D) + C.lane)[64 * j]; hd_[j] = ((const f32x4*)(H + (size_t)(row_) * D) + C.lane)[64 * j]; } } while (0)
    int row = C.gw;
    int4 slA, teA, slB, teB; f32x4 ppA, ppB, ppC;
    slA = make_int4(0, 0, 0, 0); teA = slA; slB = slA; teB = slA; ppA = (f32x4){0.f, 0.f, 0.f, 0.f}; ppB = ppA; ppC = ppA;
    u32x2 yc[4][4], yn[4][4]; f32x4 hc[4], hn[4];
    if (row < nrows) { CMB_IDX(row, slA, teA, ppA); }
    if (row + C.ngw < nrows) { CMB_IDX(row + C.ngw, slB, teB, ppB); }
    if (row < nrows) { CMB_DATA(row, slA, teA, yc, hc); }
    ppC = ppA;
    while (row < nrows) {
        const int nrow = row + C.ngw, nnrow = nrow + C.ngw;
        if (nrow < nrows) { CMB_DATA(nrow, slB, teB, yn, hn); }
        const f32x4 ppN = ppB;
        if (nnrow < nrows) { CMB_IDX(nnrow, slB, teB, ppB); }
        const float pps[4] = {ppC.x, ppC.y, ppC.z, ppC.w};
        f32x4 y[4];
#pragma unroll
        for (int j = 0; j < 4; ++j) y[j] = (f32x4){0.f, 0.f, 0.f, 0.f};
#pragma unroll
        for (int k = 0; k < 4; ++k)
#pragma unroll
            for (int j = 0; j < 4; ++j) { const u32x2 w = yc[k][j]; y[j].x += pps[k] * bf2f(w.x & 0xffffu); y[j].y += pps[k] * bf2f(w.x >> 16); y[j].z += pps[k] * bf2f(w.y & 0xffffu); y[j].w += pps[k] * bf2f(w.y >> 16); }
        const int r = row < NLAT ? (row >> 12) : 4; const f32x4* gg = (const f32x4*)(mod + r * 6144 + 5 * D) + C.lane;
        f32x4* hr = (f32x4*)((probe ? WSP(float, WS_V) : H) + (size_t)row * D) + C.lane; f32x4 v[4];
#pragma unroll
        for (int j = 0; j < 4; ++j) v[j] = hc[j] * ALPHA + gg[64 * j] * y[j];
        float mean, rstd; ln_stats(v, mean, rstd, C.lane);
#pragma unroll
        for (int j = 0; j < 4; ++j) v[j] = (v[j] - mean) * rstd * ((const f32x4*)g2)[C.lane + 64 * j] + ((const f32x4*)b2)[C.lane + 64 * j];
        if (last) { if (row < NLAT) { f32x4* orow = (f32x4*)((probe ? WSP(float, WS_V) : (float*)C.kp->out) + (size_t)row * D) + C.lane;
#pragma unroll
            for (int j = 0; j < 4; ++j) orow[64 * j] = v[j]; } }
        else {
#pragma unroll
            for (int j = 0; j < 4; ++j) hr[64 * j] = v[j];
            ln_stats(v, mean, rstd, C.lane);
            const f32x4* sh = (const f32x4*)(modn + r * 6144) + C.lane; const f32x4* sc = (const f32x4*)(modn + r * 6144 + D) + C.lane; u32x2* o = (u32x2*)((probe ? WSP(bf16_t, WS_MERGED) : U) + (size_t)row * D) + C.lane;
#pragma unroll
            for (int j = 0; j < 4; ++j) { const f32x4 yy = (v[j] - mean) * rstd * (sc[64 * j] + 1.0f) + sh[64 * j]; u32x2 w; w.x = pk2(yy.x, yy.y); w.y = pk2(yy.z, yy.w); o[64 * j] = w; } }
#pragma unroll
        for (int k = 0; k < 4; ++k)
#pragma unroll
            for (int j = 0; j < 4; ++j) yc[k][j] = yn[k][j];
#pragma unroll
        for (int j = 0; j < 4; ++j) hc[j] = hn[j];
        ppC = ppN; row = nrow;
    }
#undef CMB_IDX
#undef CMB_DATA
}

#ifndef USE_PG8
#define USE_PG8 1
#endif
#define RUN_GEMM(K_, S_, E_) gemm_pg8(C.lds, C.tid, K_, S_, E_)
constexpr int NCVT = 56;
__device__ __forceinline__ void phase_gemm_inproj(Ctx& C, int l) {
    PHASE_BEGIN(C); PIN_S(l);
    const int ngb = C.nb - NCVT;
    if (C.bid >= ngb) { phase0_transposes(C, 1, l, C.bid - ngb, NCVT); return; }
    { SchedInProj S{WSP(bf16_t, WS_U), WSP(bf16_t, WS_WIN) + (size_t)l * PT * D, ngb, C.bid};
      EpiInProj E{WSP(bf16_t, WS_P), INP(7) + (size_t)l * PT, WSP(f32x2, WS_ROPE)};
      RUN_GEMM(D, S, E); }
    { SchedVT S{WSP(bf16_t, WS_WIN) + (size_t)l * PT * D + (size_t)C_V * D, WSP(bf16_t, WS_U), ngb, (C.bid + 96) % ngb};
      EpiVT E{WSP(bf16_t, WS_VT), INP(7) + (size_t)l * PT + C_V};
      RUN_GEMM(D, S, E); }
}
struct EpiNull {
    static constexpr bool PERM = true, GATHER = false, KHOOK = false; static constexpr int HOOK0 = -1, HOOK1 = -1;
    float* dummy;
    __device__ __forceinline__ void operator()(const f32x4 (&acc)[2][2][4][2], const Unit& u, int wr, int wc, int fr, int fq) const {
        float s = 0.f;
#pragma unroll
        for (int ai = 0; ai < 2; ++ai)
#pragma unroll
            for (int bj = 0; bj < 2; ++bj)
#pragma unroll
                for (int m = 0; m < 4; ++m)
#pragma unroll
                    for (int n = 0; n < 2; ++n) s += acc[ai][bj][m][n][0] + acc[ai][bj][m][n][1] + acc[ai][bj][m][n][2] + acc[ai][bj][m][n][3];
        if (s == 123.456f) dummy[u.pm] = s;
    }
};
struct EpiPlain {
    static constexpr bool PERM = true, GATHER = false, KHOOK = false; static constexpr int HOOK0 = -1, HOOK1 = -1;
    bf16_t* O; int ldc; int contig;
    __device__ __forceinline__ void operator()(const f32x4 (&acc)[2][2][4][2], const Unit& u, int wr, int wc, int fr, int fq) const {
        const int row0 = u.pm * 256 + wr * 64 + fr, col0 = u.pn * 256 + (contig ? wc * 64 : wc * 32) + 8 * fq; const int bstep = contig ? 32 : 128;
#pragma unroll
        for (int ai = 0; ai < 2; ++ai)
#pragma unroll
            for (int m = 0; m < 4; ++m)
#pragma unroll
                for (int bj = 0; bj < 2; ++bj) { float o[8];
#pragma unroll
                    for (int n = 0; n < 2; ++n) { const f32x4 v = acc[ai][bj][m][n]; o[4 * n] = v[0]; o[4 * n + 1] = v[1]; o[4 * n + 2] = v[2]; o[4 * n + 3] = v[3]; }
                    *(u32x4*)(O + (size_t)(row0 + ai * 128 + m * 16) * ldc + col0 + bj * bstep) = pack8(o); }
    }
};
__device__ __forceinline__ void phase_gemm_inproj_probe(Ctx& C, int l, int kind) {
    PHASE_BEGIN(C); PIN_S(l);
    SchedInProj S{WSP(bf16_t, WS_U), WSP(bf16_t, WS_WIN) + (size_t)l * PT * D, C.nb, C.bid};
    if (kind == 0) { EpiNull E{WSP(float, WS_RA)}; RUN_GEMM(D, S, E); }
    else { EpiPlain E{WSP(bf16_t, WS_RA), PT, kind == 2}; RUN_GEMM(D, S, E); }
}
__device__ __forceinline__ void phase_gemm_proj(Ctx& C, int l) {
    PHASE_BEGIN(C); PIN_S(l);
    Sched2D S{WSP(bf16_t, WS_CAT), WSP(bf16_t, WS_WCAT) + (size_t)l * D * 2048, (l == 1 ? NLAT : T) / 256, D / 256, 2048, C.nb, C.bid};
    EpiMerge E{WSP(bf16_t, WS_MERGED), WSP(bf16_t, WS_P)};
    RUN_GEMM(2048, S, E);
}
__device__ __forceinline__ void phase_gemm_wo(Ctx& C, int l) {
    PHASE_BEGIN(C); PIN_S(l);
    Sched2D S{WSP(bf16_t, WS_MERGED), WSP(bf16_t, WS_WO) + (size_t)l * D * D, (l == 1 ? NLAT : T) / 256, D / 256, D, C.nb, C.bid};
    EpiWo E{l == 0 ? INP(0) : WSP(float, WS_H), l == 0 ? INP(2) - (size_t)NLAT * D : WSP(float, WS_H), WSP(bf16_t, WS_V), INP(21) + (size_t)l * D, WSP(float, WS_MOD) + (size_t)l * 5 * 6144};
    RUN_GEMM(D, S, E);
}
__device__ __forceinline__ void phase_gemm_up(Ctx& C, int l) {
    PHASE_BEGIN(C); PIN_S(l);
    build_blk(C, l);
    SchedMoE S{WSP(bf16_t, WS_U), WSP(bf16_t, WS_WGU) + (size_t)l * 32 * 2048 * D, (const LAS int*)(C.lds + 131072), 8, D, C.nb, C.bid, (size_t)2048 * D, WSP(int, WS_ETOK) + (size_t)l * 32 * ECAP, true};
    EpiSwiglu E{WSP(bf16_t, WS_RB) + (size_t)NSLOT * D, INP(27) + (size_t)l * 32 * 2048};
    RUN_GEMM(D, S, E);
}
__device__ __forceinline__ void phase_gemm_dn(Ctx& C, int l) {
    PHASE_BEGIN(C); PIN_S(l);
    build_blk(C, l);
    SchedMoE S{WSP(bf16_t, WS_RB) + (size_t)NSLOT * D, WSP(bf16_t, WS_WDN) + (size_t)l * 32 * D * D, (const LAS int*)(C.lds + 131072), 4, D, C.nb, C.bid, (size_t)D * D, WSP(int, WS_ETOK), false};
    EpiDown E{WSP(bf16_t, WS_RA), INP(29) + (size_t)l * 32 * D};
    RUN_GEMM(D, S, E);
}

__global__ void __launch_bounds__(NTHR, 2) mega(Params p) {
    extern __shared__ __attribute__((aligned(16))) unsigned char lds_raw[];
    cg::grid_group grid = cg::this_grid();
    Ctx C; C.kp = (KP)__builtin_amdgcn_kernarg_segment_ptr(); C.tid = threadIdx.x; C.bid = blockIdx.x; C.nb = gridDim.x; C.lds = (LAS unsigned char*)lds_raw; C.ws = C.kp->ws;
    if (C.tid < 64) ((LAS unsigned*)(C.lds + LDS_CTRL))[C.tid] = 0u;
    __syncthreads();
    (void)xcd_barrier_post((unsigned*)WSP(unsigned, WS_CTL) + 4096, (volatile LAS unsigned*)(C.lds + LDS_CTRL));
#define SYNC() do { PHASE_BEGIN(C); XcdBarrier bb_; bb_.bar = (unsigned*)WSP(unsigned, WS_CTL) + 4096; bb_.x = xb_xcc_id(); bb_.st = (volatile LAS unsigned*)(C.lds + LDS_CTRL); xcd_barrier(bb_); } while (0)
#ifndef PROBE
#define PROBE 0
#endif
    phase0(C); grid.sync();
    if (PROBE == 11) { phase0(C); SYNC(); }
    phase_ln0(C, 0); SYNC();
#pragma unroll 1
    for (int l = 0; l < 2; ++l) {
        const bool last = (l == 1); const int nrows = last ? NLAT : T;
        phase_gemm_inproj(C, l); SYNC();
        if (PROBE == 1) { phase_gemm_inproj(C, l); SYNC(); }
        if (PROBE == 13) { phase_gemm_inproj_probe(C, l, 0); SYNC(); }
        if (PROBE == 14) { phase_gemm_inproj_probe(C, l, 1); SYNC(); }
        if (PROBE == 19) { phase_gemm_inproj_probe(C, l, 2); SYNC(); }
        phase_lru(C, l); phase_attn3(C, l, !last); SYNC();
        if (PROBE == 8) { phase_lru(C, l); SYNC(); }
        if (PROBE == 18) { phase_lru(C, l); phase_attn3(C, l, !last, 1); SYNC(); }
        if (PROBE == 9) { phase_attn3(C, l, !last, 1); SYNC(); }
        if (PROBE == 12) { for (int k = 0; k < 5; ++k) SYNC(); }
        phase_gemm_proj(C, l); SYNC();
        if (PROBE == 2) { phase_gemm_proj(C, l); SYNC(); }
        phase_gemm_wo(C, l); SYNC();
        if (PROBE == 3) { phase_gemm_wo(C, l); SYNC(); }
        if (PROBE == 6) { phase_ln1(C, l, nrows, true); SYNC(); }
        phase_ln1(C, l, nrows); SYNC();
        phase_gemm_up(C, l); SYNC();
        if (PROBE == 4) { phase_gemm_up(C, l); SYNC(); }
        phase_gemm_dn(C, l); SYNC();
        if (PROBE == 5) { phase_gemm_dn(C, l); SYNC(); }
        if (PROBE == 7) { phase_combine(C, l, nrows, last, true); SYNC(); }
        phase_combine(C, l, nrows, last); SYNC();
    }
}

extern "C" void kernel_launch(void* const* d_in, const int* in_sizes, int n_in, void* d_out, int out_size, void* d_ws, size_t ws_size, hipStream_t stream) {
    static int grid_blocks = 0;
    if (!grid_blocks) {
        int dev = 0, cus = 0, per_cu = 0;
        (void)hipGetDevice(&dev);
        (void)hipDeviceGetAttribute(&cus, hipDeviceAttributeMultiprocessorCount, dev);
        (void)hipFuncSetAttribute((const void*)mega, hipFuncAttributeMaxDynamicSharedMemorySize, LDS_BYTES);
        (void)hipOccupancyMaxActiveBlocksPerMultiprocessor(&per_cu, (const void*)mega, NTHR, LDS_BYTES);
        if (per_cu < 1 || n_in != 32 || ws_size < WS_END) { fprintf(stderr, "kernel_launch: bad config per_cu %d n_in %d ws %zu\n", per_cu, n_in, ws_size); grid_blocks = -1; return; }
        grid_blocks = cus;
    }
    if (grid_blocks < 0) return;
    (void)hipMemsetAsync(d_ws, 0, 1 * MiB, stream);
    Params p{};
    for (int i = 0; i < 32; ++i) p.in[i] = (const GAS float*)d_in[i];
    p.out = (GAS float*)d_out; p.ws = (GAS unsigned char*)d_ws;
    void* args[] = {&p};
    hipError_t e = hipLaunchCooperativeKernel((void*)mega, dim3(grid_blocks), dim3(NTHR), args, LDS_BYTES, stream);
    if (e != hipSuccess) fprintf(stderr, "cooperative launch failed: %s (grid %d)\n", hipGetErrorString(e), grid_blocks);
}
```

```cpp
#include <hip/hip_runtime.h>
#include <hip/hip_cooperative_groups.h>
#include <cstdio>
#include <cstdint>
namespace cg = cooperative_groups;

typedef unsigned short bf16_t;
typedef short bf16x8 __attribute__((ext_vector_type(8)));
typedef float f32x4 __attribute__((ext_vector_type(4)));
typedef float f32x2 __attribute__((ext_vector_type(2)));
typedef unsigned u32x4 __attribute__((ext_vector_type(4)));
typedef unsigned u32x2 __attribute__((ext_vector_type(2)));
#define LAS __attribute__((address_space(3)))

constexpr int D = 1024, NB = 4, SEQ = 4096, CTX = 256, NLAT = NB * SEQ, NCTX = NB * CTX, T = NLAT + NCTX;
constexpr int PT = 7168, GW = 64;
constexpr int C_Q = 0, C_K = 512, C_V = 1024, C_SB = 1536, C_SCG = 2048, C_SX = 2560, C_LX = 3072, C_LG = 3584, C_GL = 4096;
constexpr int NE = 32, NSLOT = 77824, ECAP = T;
constexpr float LN_EPS = 1e-5f, ALPHA = 1.41421356237f;
constexpr int NWAVES = 8, NTHR = 512;
constexpr int LDS_BYTES = 163840;
constexpr int LDS_CTRL = 163584, LDS_LN1 = 148480;

constexpr size_t MiB = 1u << 20;
constexpr size_t WS_CTL = 0, WS_MODP = 1 * MiB, WS_MOD = 5 * MiB, WS_ROPE = 6 * MiB, WS_WIN = 8 * MiB, WS_WPA = 36 * MiB, WS_WPC = 38 * MiB, WS_WPL = 40 * MiB,
                 WS_WO = 42 * MiB, WS_WGU = 46 * MiB, WS_WDN = 302 * MiB, WS_H = 430 * MiB, WS_V = 498 * MiB, WS_U = 566 * MiB, WS_P = 600 * MiB, WS_ATT = 838 * MiB,
                 WS_SC = 855 * MiB, WS_LRU = 872 * MiB, WS_MERGED = 889 * MiB, WS_SMALL = 923 * MiB, WS_XM = 927 * MiB, WS_RA = 961 * MiB, WS_RB = 1165 * MiB, WS_WPL2 = 1469 * MiB, WS_ETOK = 1473 * MiB, WS_WCAT = 1478 * MiB, WS_END = 1486 * MiB;
constexpr size_t WS_CAT = WS_RB;
constexpr size_t WS_VT = WS_LRU;
constexpr size_t WS_LRU2 = WS_XM;
#define GAS __attribute__((address_space(1)))
struct Params {
    const GAS float* in[32];
    GAS float* out;
    GAS unsigned char* ws;
};

__device__ __forceinline__ float bf2f(unsigned v) { return __uint_as_float(v << 16); }
__device__ __forceinline__ unsigned f2bf(float f) { unsigned u = __float_as_uint(f); return (u + 0x7fffu + ((u >> 16) & 1u)) >> 16; }
typedef __bf16 bf16x2_t __attribute__((ext_vector_type(2)));
__device__ __forceinline__ unsigned pk2(float lo, float hi) { const f32x2 v = {lo, hi}; const bf16x2_t b = __builtin_convertvector(v, bf16x2_t); return __builtin_bit_cast(unsigned, b); }
__device__ __forceinline__ float sigmoidf_(float x) { return __builtin_amdgcn_rcpf(1.0f + __expf(-x)); }
__device__ __forceinline__ float wave_sum(float v, int lane) {
    (void)lane;
    v += __int_as_float(__builtin_amdgcn_update_dpp(0, __float_as_int(v), 0xB1, 0xF, 0xF, true));
    v += __int_as_float(__builtin_amdgcn_update_dpp(0, __float_as_int(v), 0x4E, 0xF, 0xF, true));
    v += __int_as_float(__builtin_amdgcn_update_dpp(0, __float_as_int(v), 0x124, 0xF, 0xF, true));
    v += __int_as_float(__builtin_amdgcn_update_dpp(0, __float_as_int(v), 0x128, 0xF, 0xF, true));
    const float r0 = __int_as_float(__builtin_amdgcn_readlane(__float_as_int(v), 0)), r1 = __int_as_float(__builtin_amdgcn_readlane(__float_as_int(v), 16));
    const float r2 = __int_as_float(__builtin_amdgcn_readlane(__float_as_int(v), 32)), r3 = __int_as_float(__builtin_amdgcn_readlane(__float_as_int(v), 48));
    return (r0 + r1) + (r2 + r3);
}
__device__ __forceinline__ float bperm(int srclane, float v) { return __int_as_float(__builtin_amdgcn_ds_bpermute(srclane << 2, __float_as_int(v))); }
__device__ __forceinline__ void unpack8(const u32x4 w, float* f) {
    f[0] = bf2f(w.x & 0xffffu); f[1] = bf2f(w.x >> 16); f[2] = bf2f(w.y & 0xffffu); f[3] = bf2f(w.y >> 16);
    f[4] = bf2f(w.z & 0xffffu); f[5] = bf2f(w.z >> 16); f[6] = bf2f(w.w & 0xffffu); f[7] = bf2f(w.w >> 16);
}
__device__ __forceinline__ u32x4 pack8(const float* f) { u32x4 w; w.x = pk2(f[0], f[1]); w.y = pk2(f[2], f[3]); w.z = pk2(f[4], f[5]); w.w = pk2(f[6], f[7]); return w; }
__device__ __forceinline__ int perm32(int rho) { const int n = rho >> 4, i = rho & 15; return 8 * (i >> 2) + 4 * n + (i & 3); }
__device__ __forceinline__ float gelu_tanh(float x) { const float u = 0.7978845608028654f * (x + 0.044715f * x * x * x); return 0.5f * x * (1.0f + tanhf(u)); }

struct Unit { int pm, pn, aux, nvalid; const bf16_t* A; const bf16_t* B; const int* idx; };
#define PG8_LAS __attribute__((address_space(3)))
constexpr int BM = 256, BK = 64, HALF = 128, HTB = HALF * BK * 2, STAGE_BYTES = 8 * HTB;
__host__ __device__ __forceinline__ int lds_byte(int r, int c) { const int st = (r >> 4) * 2 + (c >> 5), rr = r & 15, cc = c & 31, ob = rr * 64 + cc * 2; return st * 1024 + (ob ^ (((ob >> 9) & 1) << 5)); }
__host__ __device__ __forceinline__ void stage_rc(int b, int& R, int& C) { const int st = b / 1024, sb = b % 1024, swz = sb ^ (((sb >> 9) & 1) << 5); R = (st >> 1) * 16 + swz / 64; C = (st & 1) * 32 + (swz % 64) / 2; }
template <class Epi, class Sched>
__device__ __forceinline__ void gemm_pg8(PG8_LAS unsigned char* lds, int tid, const int K, const Sched& S, const Epi& E) {
    const int wid = __builtin_amdgcn_readfirstlane(tid >> 6), lane = tid & 63, wr = wid >> 2, wc = wid & 3, fr = lane & 15, fq = lane >> 4;
    const int nt = K / BK;
    unsigned voffB[2]; int RA[2], CA[2];
#pragma unroll
    for (int i = 0; i < 2; ++i) { int R, Cc; stage_rc(tid * 16 + i * 8192, R, Cc); const int Rb = Epi::PERM ? ((R & ~31) + perm32(R & 31)) : R;
        RA[i] = R; CA[i] = Cc; voffB[i] = (unsigned)(Rb * K + Cc) * 2u; }
    const size_t kstep = (size_t)(BK * 2);
    const size_t hstep = (size_t)HALF * K * 2;
    const unsigned ldsw = (unsigned)wid * 1024u;
    const int aoff = lds_byte(wr * 64 + fr, fq * 8), boff = lds_byte(wc * 32 + fr, fq * 8);
#define PG8_SA(b, h) (((b) * 2 + (h)) * HTB)
#define PG8_SB(b, h) ((4 + (b) * 2 + (h)) * HTB)
#define PG8_STAGE(bufoff, gbase, voff) do { _Pragma("unroll") for (int _i = 0; _i < 2; ++_i) \
        __builtin_amdgcn_global_load_lds((const unsigned*)((const char*)(gbase) + (voff)[_i]), (PG8_LAS unsigned*)(lds + (bufoff) + ldsw + _i * 8192), 16, 0, 0); } while (0)
#define PG8_LDA(dst, b, h) do { _Pragma("unroll") for (int m = 0; m < 4; ++m) _Pragma("unroll") for (int k = 0; k < 2; ++k) dst[m][k] = *(const PG8_LAS bf16x8*)(lds + PG8_SA(b, h) + aoff + m * 2048 + k * 1024); } while (0)
#define PG8_LDB(dst, b, h) do { _Pragma("unroll") for (int n = 0; n < 2; ++n) _Pragma("unroll") for (int k = 0; k < 2; ++k) dst[n][k] = *(const PG8_LAS bf16x8*)(lds + PG8_SB(b, h) + boff + n * 2048 + k * 1024); } while (0)
#define PG8_MMA(ai, bj, At, Bt) do { __builtin_amdgcn_s_setprio(1); _Pragma("unroll") for (int m = 0; m < 4; ++m) _Pragma("unroll") for (int n = 0; n < 2; ++n) _Pragma("unroll") for (int k = 0; k < 2; ++k) \
        acc[ai][bj][m][n] = __builtin_amdgcn_mfma_f32_16x16x32_bf16(Bt[n][k], At[m][k], acc[ai][bj][m][n], 0, 0, 0); __builtin_amdgcn_s_setprio(0); } while (0)
#define PG8_WAIT_V(n) asm volatile("s_waitcnt vmcnt(" #n ")" ::: "memory")
#define PG8_WAIT_L(n) asm volatile("s_waitcnt lgkmcnt(" #n ")" ::: "memory")
#define PG8_BAR __builtin_amdgcn_s_barrier()
#define PG8_SCHED __builtin_amdgcn_sched_barrier(0)
#define PG8_VA(dst, u) do { _Pragma("unroll") for (int _h = 0; _h < 2; ++_h) _Pragma("unroll") for (int _i = 0; _i < 2; ++_i) { \
        if constexpr (Epi::GATHER) { const int _p = _h * HALF + RA[_i]; const int _tok = _p < (u).nvalid ? (u).idx[_p] : 0; dst[_h][_i] = (unsigned)(_tok * K + CA[_i]) * 2u; } \
        else dst[_h][_i] = (unsigned)((_h * HALF + RA[_i]) * K + CA[_i]) * 2u; } } while (0)
    Unit cur, nxt; int ui = 0;
    if (!S.next(0, cur)) return;
    f32x4 acc[2][2][4][2];
#pragma unroll
    for (int a = 0; a < 2; ++a)
#pragma unroll
        for (int b = 0; b < 2; ++b)
#pragma unroll
            for (int m = 0; m < 4; ++m)
#pragma unroll
                for (int n = 0; n < 2; ++n) acc[a][b][m][n] = (f32x4){0.f, 0.f, 0.f, 0.f};
    bf16x8 At[4][2], B0[2][2], B1[2][2];
    unsigned vAc[2][2], vAn[2][2];
    PG8_VA(vAc, cur);
    const char* cA = (const char*)cur.A; const char* cB = (const char*)cur.B;
    PG8_STAGE(PG8_SB(0, 0), cB, voffB); PG8_STAGE(PG8_SB(0, 1), cB + hstep, voffB); PG8_STAGE(PG8_SA(0, 0), cA, vAc[0]); PG8_STAGE(PG8_SA(0, 1), cA, vAc[1]);
    if (wr == 1) PG8_BAR;
    PG8_WAIT_V(2); PG8_BAR;
    PG8_STAGE(PG8_SB(1, 0), cB + kstep, voffB); PG8_STAGE(PG8_SA(1, 0), cA + kstep, vAc[0]); PG8_STAGE(PG8_SB(1, 1), cB + hstep + kstep, voffB);
    PG8_WAIT_V(6); PG8_BAR;
    for (;;) {
        const bool has_next = S.next(ui + 1, nxt);
        const char* nA = has_next ? (const char*)nxt.A : cA; const char* nB = has_next ? (const char*)nxt.B : cB;
        if (Epi::GATHER && has_next) PG8_VA(vAn, nxt);
        else {
#pragma unroll
            for (int h = 0; h < 2; ++h) { vAn[h][0] = vAc[h][0]; vAn[h][1] = vAc[h][1]; } }
        for (int t = 0; t < nt; t += 2) {
            const bool last = (t == nt - 2);
            const char* a1 = cA + (size_t)(t + 1) * kstep;
            const char* a2 = last ? nA : cA + (size_t)(t + 2) * kstep; const char* b2 = last ? nB : cB + (size_t)(t + 2) * kstep;
            const char* a3 = a2 + kstep; const char* b3 = b2 + kstep;
            unsigned v2[2][2];
#pragma unroll
            for (int h = 0; h < 2; ++h) { v2[h][0] = (Epi::GATHER && last) ? vAn[h][0] : vAc[h][0]; v2[h][1] = (Epi::GATHER && last) ? vAn[h][1] : vAc[h][1]; }
            PG8_LDB(B0, 0, 0); PG8_LDB(B1, 0, 1); PG8_SCHED; PG8_LDA(At, 0, 0); PG8_STAGE(PG8_SA(1, 1), a1, vAc[1]);
            PG8_WAIT_V(8); PG8_WAIT_L(0); PG8_BAR; PG8_MMA(0, 0, At, B0); PG8_MMA(0, 1, At, B1); PG8_BAR; PG8_SCHED;
            PG8_LDA(At, 0, 1); PG8_STAGE(PG8_SB(0, 0), b2, voffB); PG8_STAGE(PG8_SB(0, 1), b2 + hstep, voffB); PG8_STAGE(PG8_SA(0, 0), a2, v2[0]);
            PG8_WAIT_V(8); PG8_WAIT_L(0); PG8_BAR; PG8_MMA(1, 0, At, B0); PG8_MMA(1, 1, At, B1); PG8_BAR; PG8_SCHED;
            PG8_LDB(B0, 1, 0); PG8_LDB(B1, 1, 1); PG8_SCHED; PG8_LDA(At, 1, 0); PG8_STAGE(PG8_SA(0, 1), a2, v2[1]);
            PG8_WAIT_V(8); PG8_WAIT_L(0); PG8_BAR; PG8_MMA(0, 0, At, B0); PG8_MMA(0, 1, At, B1); PG8_BAR; PG8_SCHED;
            PG8_LDA(At, 1, 1); PG8_STAGE(PG8_SB(1, 0), b3, voffB); PG8_STAGE(PG8_SB(1, 1), b3 + hstep, voffB); PG8_STAGE(PG8_SA(1, 0), a3, v2[0]);
            PG8_WAIT_V(8); PG8_WAIT_L(0); PG8_BAR; PG8_MMA(1, 0, At, B0); PG8_MMA(1, 1, At, B1); PG8_BAR; PG8_SCHED;
            if constexpr (Epi::KHOOK) { if (t + 2 == Epi::HOOK0 || t + 2 == Epi::HOOK1) E.khook(acc, cur, t + 2, wr, wc, fr, fq); }
        }
        if (wr == 0) PG8_BAR;
        E(acc, cur, wr, wc, fr, fq);
        if (!has_next) break;
#pragma unroll
        for (int a = 0; a < 2; ++a)
#pragma unroll
            for (int b = 0; b < 2; ++b)
#pragma unroll
                for (int m = 0; m < 4; ++m)
#pragma unroll
                    for (int n = 0; n < 2; ++n) acc[a][b][m][n] = (f32x4){0.f, 0.f, 0.f, 0.f};
        cur = nxt; cA = nA; cB = nB; ++ui;
#pragma unroll
        for (int h = 0; h < 2; ++h) { vAc[h][0] = vAn[h][0]; vAc[h][1] = vAn[h][1]; }
        if (wr == 1) PG8_BAR;
    }
    PG8_WAIT_V(0);
    PG8_BAR;
#undef PG8_SA
#undef PG8_SB
#undef PG8_STAGE
#undef PG8_LDA
#undef PG8_LDB
#undef PG8_MMA
#undef PG8_WAIT_V
#undef PG8_WAIT_L
#undef PG8_BAR
#undef PG8_SCHED
#undef PG8_VA
}
__device__ __forceinline__ int xcd_chunk(int L, int nwg) { const int q = nwg / 8, r = nwg % 8, x = L % 8, off = L / 8; return (x < r ? x * (q + 1) : r * (q + 1) + (x - r) * q) + off; }
__device__ __forceinline__ void grouped_pm_pn(int wgid, int nM, int nN, int& pm, int& pn) {
    const int nig = 8 * nN, gid = wgid / nig, fm = gid * 8, gsz = (nM - fm) < 8 ? (nM - fm) : 8; pm = fm + ((wgid % nig) % gsz); pn = (wgid % nig) / gsz; }
struct Sched2D {
    const bf16_t* A; const bf16_t* B; int nM, nN, K, G, c;
    __device__ __forceinline__ bool next(int i, Unit& u) const {
        const int L = i * G + c, nwg = nM * nN; if (L >= nwg) return false;
        grouped_pm_pn(xcd_chunk(L, nwg), nM, nN, u.pm, u.pn); u.aux = 0; u.nvalid = 0; u.idx = nullptr; u.A = A + (size_t)u.pm * 256 * K; u.B = B + (size_t)u.pn * 256 * K; return true;
    }
};
struct SchedInProj {
    const bf16_t* A; const bf16_t* B; int G, c;
    __device__ __forceinline__ bool next(int i, Unit& u) const {
        const int L = i * G + c, nwg = (T / 256) * 26; if (L >= nwg) return false;
        int q; grouped_pm_pn(xcd_chunk(L, nwg), T / 256, 26, u.pm, q); u.pn = q < 4 ? q : q + 2; u.aux = 0; u.nvalid = 0; u.idx = nullptr;
        u.A = A + (size_t)u.pm * 256 * D; u.B = B + (size_t)u.pn * 256 * D; return true;
    }
};
struct SchedVT {
    const bf16_t* A; const bf16_t* B; int G, c;
    __device__ __forceinline__ bool next(int i, Unit& u) const {
        const int L0 = i * G + c, nwg = 2 * (T / 256); if (L0 >= nwg) return false;
        const int L = xcd_chunk(L0, nwg); u.pm = L & 1; u.pn = L >> 1; u.aux = 0; u.nvalid = 0; u.idx = nullptr; u.A = A + (size_t)u.pm * 256 * D; u.B = B + (size_t)u.pn * 256 * D; return true;
    }
};
struct EpiVT {
    static constexpr bool PERM = true, GATHER = false, KHOOK = false; static constexpr int HOOK0 = -1, HOOK1 = -1;
    bf16_t* VT; const float* bv;
    __device__ __forceinline__ void operator()(const f32x4 (&acc)[2][2][4][2], const Unit& u, int wr, int wc, int fr, int fq) const {
        const int row0 = u.pm * 256 + wr * 64 + fr, col0 = u.pn * 256 + wc * 32 + 8 * fq;
#pragma unroll
        for (int ai = 0; ai < 2; ++ai)
#pragma unroll
            for (int m = 0; m < 4; ++m) { const int row = row0 + ai * 128 + m * 16; const float bb = bv[row];
#pragma unroll
                for (int bj = 0; bj < 2; ++bj) { float o[8];
#pragma unroll
                    for (int n = 0; n < 2; ++n) { const f32x4 v = acc[ai][bj][m][n]; o[4 * n] = v[0] + bb; o[4 * n + 1] = v[1] + bb; o[4 * n + 2] = v[2] + bb; o[4 * n + 3] = v[3] + bb; }
                    *(u32x4*)(VT + (size_t)row * T + col0 + bj * 128) = pack8(o); } }
    }
};
struct SchedMoE {
    const bf16_t* A; const bf16_t* B; const LAS int* blk; int nN, K, G, c; size_t bstride; const int* etok; bool gather;
    __device__ __forceinline__ bool next(int i, Unit& u) const {
        const int L0 = i * G + c, nwg = blk[32] * nN; if (L0 >= nwg) return false;
        const int L = xcd_chunk(L0, nwg);
        int e = 0;
#pragma unroll 1
        for (int j = 1; j < 32; ++j) if (L >= blk[j] * nN) e = j;
        const int r = L - blk[e] * nN;
        const int rb = r / nN; u.pn = r % nN; u.pm = blk[e] + rb; u.aux = e;
        u.nvalid = blk[64 + e] - rb * 256; u.idx = etok + (size_t)e * ECAP + rb * 256;
        u.A = gather ? A : A + (size_t)u.pm * 256 * K; u.B = B + (size_t)e * bstride + (size_t)u.pn * 256 * K; return true;
    }
};

struct EpiMerge {
    static constexpr bool PERM = true, GATHER = false, KHOOK = true; static constexpr int HOOK0 = 8, HOOK1 = 16;
    bf16_t* M; const bf16_t* P;
    __device__ __forceinline__ void khook(f32x4 (&acc)[2][2][4][2], const Unit& u, int kt, int wr, int wc, int fr, int fq) const {
        const int row0 = u.pm * 256 + wr * 64 + fr, col0 = u.pn * 256 + wc * 32 + 8 * fq; const int ja = kt == HOOK0 ? 0 : 1;
        const GAS bf16_t* g = (const GAS bf16_t*)(P + (size_t)row0 * PT + C_GL + ja * D + col0);
#pragma unroll
        for (int ai = 0; ai < 2; ++ai) {
#pragma unroll
            for (int m = 0; m < 4; ++m) {
#pragma unroll
                for (int bj = 0; bj < 2; ++bj) { float sa[8], sb[8]; unpack8(*(const GAS u32x4*)(g + bj * 128), sa); unpack8(*(const GAS u32x4*)(g + D + bj * 128), sb);
#pragma unroll
                    for (int n = 0; n < 2; ++n)
#pragma unroll
                        for (int j = 0; j < 4; ++j) acc[ai][bj][m][n][j] *= sa[4 * n + j] * __builtin_amdgcn_rcpf(sb[4 * n + j]); }
                g += (size_t)16 * PT; if (m == 3) asm volatile("" : "+v"(g) :: "memory"); }
            g += (size_t)64 * PT; }
    }
    __device__ __forceinline__ void operator()(const f32x4 (&acc)[2][2][4][2], const Unit& u, int wr, int wc, int fr, int fq) const {
        const int row0 = u.pm * 256 + wr * 64 + fr, col0 = u.pn * 256 + wc * 32 + 8 * fq;
        const GAS bf16_t* g = (const GAS bf16_t*)(P + (size_t)row0 * PT + C_GL + 2 * D + col0); GAS bf16_t* mo = (GAS bf16_t*)(M + (size_t)row0 * D + col0);
#pragma unroll
        for (int ai = 0; ai < 2; ++ai) {
#pragma unroll
            for (int m = 0; m < 4; ++m) {
#pragma unroll
                for (int bj = 0; bj < 2; ++bj) { float s2[8], o[8]; unpack8(*(const GAS u32x4*)(g + bj * 128), s2);
#pragma unroll
                    for (int n = 0; n < 2; ++n)
#pragma unroll
                        for (int j = 0; j < 4; ++j) o[4 * n + j] = acc[ai][bj][m][n][j] * s2[4 * n + j];
                    *(GAS u32x4*)(mo + bj * 128) = pack8(o); }
                g += (size_t)16 * PT; mo += (size_t)16 * D; if (m == 3) asm volatile("" : "+v"(g), "+v"(mo) :: "memory"); }
            g += (size_t)64 * PT; mo += (size_t)64 * D; }
    }
};
struct EpiInProj {
    static constexpr bool PERM = true, GATHER = false, KHOOK = false; static constexpr int HOOK0 = -1, HOOK1 = -1;
    bf16_t* P; const float* bias; const f32x2* rope;
    __device__ __forceinline__ void operator()(const f32x4 (&acc)[2][2][4][2], const Unit& u, int wr, int wc, int fr, int fq) const {
        const int row0 = u.pm * 256 + wr * 64 + fr, col0 = u.pn * 256 + wc * 32 + 8 * fq;
        const bool ropet = (u.pn < 4), gate = (u.pn >= 16);
        const bool upper = fq >= 2; const int fi0 = 8 * (fq & 1);
#pragma unroll
        for (int ai = 0; ai < 2; ++ai)
#pragma unroll
            for (int m = 0; m < 4; ++m) {
                const int row = row0 + ai * 128 + m * 16;
                const int s = row & (SEQ - 1); const int pos = (wc & 1) ? (s & 63) : (s >> 6);
                const bool dorope = ropet && (row < NLAT);
#pragma unroll
                for (int bj = 0; bj < 2; ++bj) {
                    float o[8];
#pragma unroll
                    for (int n = 0; n < 2; ++n) { const f32x4 v = acc[ai][bj][m][n] + *(const f32x4*)(bias + col0 + bj * 128 + 4 * n); o[4 * n] = v[0]; o[4 * n + 1] = v[1]; o[4 * n + 2] = v[2]; o[4 * n + 3] = v[3]; }
                    if (gate) {
#pragma unroll
                        for (int j = 0; j < 8; ++j) o[j] = fmaxf(sigmoidf_(o[j]), 1e-20f); }
                    if (ropet) {
#pragma unroll
                        for (int j = 0; j < 8; ++j) { const auto rr = __builtin_amdgcn_permlane32_swap(__float_as_uint(o[j]), __float_as_uint(o[j]), false, false);
                            const float partner = __uint_as_float(upper ? rr[0] : rr[1]); const f32x2 cs = rope[pos * 16 + fi0 + j];
                            const float rot = upper ? (partner * cs.y + o[j] * cs.x) : (o[j] * cs.x - partner * cs.y);
                            o[j] = dorope ? rot : o[j]; } }
                    *(u32x4*)(P + (size_t)row * PT + col0 + bj * 128) = pack8(o);
                }
            }
    }
};
struct EpiWo {
    static constexpr bool PERM = true, GATHER = false, KHOOK = false; static constexpr int HOOK0 = -1, HOOK1 = -1;
    const float* h; const float* hc; bf16_t* V; const float* bo; const float* mod;
    __device__ __forceinline__ void operator()(const f32x4 (&acc)[2][2][4][2], const Unit& u, int wr, int wc, int fr, int fq) const {
        const int row0 = u.pm * 256 + wr * 64 + fr, col0 = u.pn * 256 + wc * 32 + 8 * fq;
#pragma unroll
        for (int ai = 0; ai < 2; ++ai)
#pragma unroll
            for (int m = 0; m < 4; ++m) {
                const int row = row0 + ai * 128 + m * 16; const int r = row < NLAT ? (row >> 12) : 4;
                const float* g1 = mod + r * 6144 + 2 * D;
#pragma unroll
                for (int bj = 0; bj < 2; ++bj) { const int col = col0 + bj * 128; const size_t off = (size_t)row * D + col; float o[8];
#pragma unroll
                    for (int n = 0; n < 2; ++n) { const f32x4 y = acc[ai][bj][m][n] + *(const f32x4*)(bo + col + 4 * n);
                        const f32x4 v = *(const f32x4*)((u.pm < NLAT / 256 ? h : hc) + off + 4 * n) * ALPHA + *(const f32x4*)(g1 + col + 4 * n) * y; o[4 * n] = v[0]; o[4 * n + 1] = v[1]; o[4 * n + 2] = v[2]; o[4 * n + 3] = v[3]; }
                    *(u32x4*)(V + off) = pack8(o); }
            }
    }
};
struct EpiSwiglu {
    static constexpr bool PERM = true, GATHER = true , KHOOK = false; static constexpr int HOOK0 = -1, HOOK1 = -1;
    bf16_t* H; const float* bgu;
    __device__ __forceinline__ void operator()(const f32x4 (&acc)[2][2][4][2], const Unit& u, int wr, int wc, int fr, int fq) const {
        const int row0 = u.pm * 256 + wr * 64 + fr, hc0 = u.pn * 128 + wc * 32 + 8 * fq;
        const float* bg = bgu + u.aux * 2048 + hc0; const float* bu = bg + 1024;
        f32x4 bgv[2], buv[2];
#pragma unroll
        for (int n = 0; n < 2; ++n) { bgv[n] = *(const f32x4*)(bg + 4 * n); buv[n] = *(const f32x4*)(bu + 4 * n); }
#pragma unroll
        for (int ai = 0; ai < 2; ++ai)
#pragma unroll
            for (int m = 0; m < 4; ++m) {
                float o[8];
#pragma unroll
                for (int n = 0; n < 2; ++n) { const f32x4 g = acc[ai][0][m][n] + bgv[n], up = acc[ai][1][m][n] + buv[n];
#pragma unroll
                    for (int j = 0; j < 4; ++j) { const float gg = fminf(g[j], 7.0f), uu = fminf(fmaxf(up[j], -7.0f), 7.0f); o[4 * n + j] = (uu + 1.0f) * gg * sigmoidf_(1.702f * gg); } }
                *(u32x4*)(H + (size_t)(row0 + ai * 128 + m * 16) * D + hc0) = pack8(o);
            }
    }
};
struct EpiDown {
    static constexpr bool PERM = true, GATHER = false, KHOOK = false; static constexpr int HOOK0 = -1, HOOK1 = -1;
    bf16_t* Y; const float* bdn;
    __device__ __forceinline__ void operator()(const f32x4 (&acc)[2][2][4][2], const Unit& u, int wr, int wc, int fr, int fq) const {
        const int row0 = u.pm * 256 + wr * 64 + fr, col0 = u.pn * 256 + wc * 32 + 8 * fq;
        const float* bb = bdn + u.aux * 1024 + col0;
#pragma unroll
        for (int ai = 0; ai < 2; ++ai)
#pragma unroll
            for (int m = 0; m < 4; ++m)
#pragma unroll
                for (int bj = 0; bj < 2; ++bj) { float o[8];
#pragma unroll
                    for (int n = 0; n < 2; ++n) { const f32x4 v = acc[ai][bj][m][n] + *(const f32x4*)(bb + bj * 128 + 4 * n); o[4 * n] = v[0]; o[4 * n + 1] = v[1]; o[4 * n + 2] = v[2]; o[4 * n + 3] = v[3]; }
                    *(u32x4*)(Y + (size_t)(row0 + ai * 128 + m * 16) * D + col0 + bj * 128) = pack8(o); }
    }
};

typedef GAS unsigned gu32;
#define XB_TMO      128
#define XB_XCNT(j)  (256  + 64 * (j))
#define XB_XSUB(j)  (1280 + 64 * (j))
#define XB_XGEN(j)  (2304 + 64 * (j))
#define XB_TOP      3328
#define XB_TOPGEN   3392
#define XCD_BAR_WORDS 3456
#define XB_SPIN_CAP (1u << 18)

__device__ __forceinline__ unsigned xb_ld(unsigned* p)              { return __hip_atomic_load(p, __ATOMIC_RELAXED, __HIP_MEMORY_SCOPE_AGENT); }
__device__ __forceinline__ unsigned xb_add(unsigned* p, unsigned v) { return __hip_atomic_fetch_add(p, v, __ATOMIC_RELAXED, __HIP_MEMORY_SCOPE_AGENT); }
__device__ __forceinline__ unsigned xb_xcc_id() { return (unsigned)__builtin_amdgcn_s_getreg((3 << 11) | 20) & 0xFu; }
#define XB_SPIN(cond, bar) do { unsigned _sp = 0; while (cond) { __builtin_amdgcn_s_sleep(1); \
    if ((++_sp & 255u) == 0u) { if (xb_ld(&(bar)[XB_TMO])) break; if (_sp > XB_SPIN_CAP) { atomicAdd(&(bar)[XB_TMO], 1u); break; } } } } while (0)

struct XcdBarrier {
    unsigned* bar; unsigned x;
    volatile LAS unsigned* st;
};

__device__ __forceinline__ XcdBarrier xcd_barrier_post(unsigned* bar, volatile LAS unsigned* st) {
    XcdBarrier b; b.bar = bar; b.x = xb_xcc_id(); b.st = st;
    if (threadIdx.x == 0) (void)xb_add(&bar[XB_XCNT(b.x)], 1u);
    return b;
}
__device__ __forceinline__ void xcd_barrier_complete(unsigned* bar, unsigned x, unsigned& nloc, unsigned& nx) {
    const unsigned G = gridDim.x * gridDim.y * gridDim.z;
    unsigned sum, cnt, mine, sp = 0u;
    for (;;) {
        sum = 0u; cnt = 0u; mine = 0u;
#pragma unroll
        for (unsigned j = 0; j < 16; ++j) { const unsigned c = xb_ld(&bar[XB_XCNT(j)]); sum += c; cnt += (c > 0u) ? 1u : 0u; mine = (j == x) ? c : mine; }
        if (sum == G) break;
        __builtin_amdgcn_s_sleep(1);
        if ((++sp & 255u) == 0u) { if (xb_ld(&bar[XB_TMO])) break; if (sp > XB_SPIN_CAP) { atomicAdd(&bar[XB_TMO], 1u); break; } }
    }
    nloc = mine > 0u ? mine : 1u; nx = cnt > 0u ? cnt : 1u;
}

__device__ __forceinline__ void xcd_barrier(const XcdBarrier& b) {
    asm volatile("s_waitcnt vmcnt(0)" ::: "memory");
    __syncthreads();
    if (threadIdx.x == 0) {
        unsigned* bar = b.bar;
        __builtin_amdgcn_s_waitcnt(0);
        unsigned nloc = b.st[0], nx = b.st[1];
        if (nloc == 0u) { xcd_barrier_complete(bar, b.x, nloc, nx); b.st[0] = nloc; b.st[1] = nx; }
        const unsigned old = xb_add(&bar[XB_XSUB(b.x)], 1u);
        const unsigned gen = old / nloc;
        if (old + 1u == (gen + 1u) * nloc) {
            __builtin_amdgcn_fence(__ATOMIC_RELEASE, "agent");
            asm volatile("s_waitcnt vmcnt(0)" ::: "memory");
            const unsigned og = xb_add(&bar[XB_TOP], 1u);
            const unsigned tg = og / nx;
            if (og + 1u == (tg + 1u) * nx) xb_add(&bar[XB_TOPGEN], 1u);
            else XB_SPIN(xb_ld(&bar[XB_TOPGEN]) == tg, bar);
            __builtin_amdgcn_fence(__ATOMIC_ACQUIRE, "agent");
            xb_add(&bar[XB_XGEN(b.x)], 1u);
            asm volatile("s_waitcnt vmcnt(0)" ::: "memory");
        } else {
            XB_SPIN(xb_ld(&bar[XB_XGEN(b.x)]) == gen, bar);
            __builtin_amdgcn_fence(__ATOMIC_ACQUIRE, "agent");
            asm volatile("s_waitcnt vmcnt(0)" ::: "memory");
        }
    }
    __syncthreads();
}

typedef const __attribute__((address_space(4))) Params* KP;
struct Ctx {
    KP kp; int tid, lane, wave, bid, nb, gw, ngw; size_t gtid, gthr; LAS unsigned char* lds;
    GAS unsigned char* ws;
};
#define PHASE_BEGIN(C) do { asm volatile("" : "+s"(C.kp)); asm volatile("" : "+s"(C.ws)); asm volatile("" : "+v"(C.tid)); asm volatile("" : "+s"(C.bid)); asm volatile("" : "+s"(C.lds)); \
    C.lane = C.tid & 63; C.wave = __builtin_amdgcn_readfirstlane(C.tid >> 6); C.gw = C.bid * NWAVES + C.wave; C.ngw = C.nb * NWAVES; \
    C.gtid = (size_t)C.bid * NTHR + C.tid; C.gthr = (size_t)C.nb * NTHR; } while (0)
#define PIN_S(x) asm volatile("" : "+s"(x))
#define WSP(T_, off) ((T_*)(GAS T_*)(C.ws + (off)))
#define INP(i) ((const float*)C.kp->in[i])

struct TrFam { const float* W; bf16_t* WT; int nmat, K, N, ldk, koff, gu, first; };
__device__ __forceinline__ void tr_decode(const TrFam& F, int it, const float*& src, bf16_t*& dst, int& d0, int& d1, int& Nn, int& ldk) {
    const int nnb = F.N / 256, per = (F.K / 128) * nnb; const int r0 = it - F.first, mi = r0 / per, r = r0 % per, kb = r / nnb, n0 = (r % nnb) * 256;
    src = F.W + (size_t)mi * F.K * F.N + (size_t)(kb * 128) * F.N + n0; dst = F.WT + (size_t)mi * F.ldk * F.N + F.koff + kb * 128; Nn = F.N; ldk = F.ldk;
    if (F.gu) { const int bj = n0 >> 10, j = n0 & 1023; d0 = 256 * (j >> 7) + 128 * bj; d1 = 256 * ((j + 128) >> 7) + 128 * bj; } else { d0 = n0; d1 = n0 + 128; }
}
__device__ __forceinline__ void phase0_transposes(Ctx& C, int which, int lsel, int bi, int nbk) {
    TrFam F[6]; int tot = 0;
    if (which == 0) {
      const float* srcs[6] = {INP(6), INP(9), INP(10), INP(11), INP(11), INP(20)};
      bf16_t* dsts[6] = {WSP(bf16_t, WS_WIN), WSP(bf16_t, WS_WCAT), WSP(bf16_t, WS_WCAT), WSP(bf16_t, WS_WCAT), WSP(bf16_t, WS_WCAT), WSP(bf16_t, WS_WO)};
      const int Ks[6] = {D, 512, 512, 512, 512, D}, Ns[6] = {PT, D, D, D, D, D}, ld[6] = {D, 2048, 2048, 2048, 2048, D}, ko[6] = {0, 0, 512, 1024, 1536, 0};
#pragma unroll
      for (int f = 0; f < 6; ++f) { F[f].W = srcs[f]; F[f].WT = dsts[f]; F[f].nmat = 2; F[f].K = Ks[f]; F[f].N = Ns[f]; F[f].ldk = ld[f]; F[f].koff = ko[f]; F[f].gu = 0; F[f].first = tot; tot += 2 * (Ks[f] / 128) * (Ns[f] / 256); }
    } else {
      F[0].W = INP(26) + (size_t)lsel * 32 * D * 2048; F[0].WT = WSP(bf16_t, WS_WGU) + (size_t)lsel * 32 * 2048 * D; F[0].nmat = 32; F[0].K = D; F[0].N = 2048; F[0].ldk = D; F[0].koff = 0; F[0].gu = 1; F[0].first = 0; tot = 32 * 8 * 8;
      F[1].W = INP(28) + (size_t)lsel * 32 * D * D; F[1].WT = WSP(bf16_t, WS_WDN) + (size_t)lsel * 32 * D * D; F[1].nmat = 32; F[1].K = D; F[1].N = D; F[1].ldk = D; F[1].koff = 0; F[1].gu = 0; F[1].first = tot; tot += 32 * 8 * 4;
#pragma unroll
      for (int f = 2; f < 6; ++f) { F[f] = F[1]; F[f].first = 0x7fffffff; }
    }
    const int lane = C.lane, w = C.wave;
    f32x4 va[16], vb[16];
    const float* src; bf16_t* dst; int d0, d1, Nn, ldk;
    bf16_t* dstA = nullptr; bf16_t* dstB = nullptr; int d0A = 0, d1A = 0, ldA = 0, d0B = 0, d1B = 0, ldB = 0;
#define TR_FIND(it_) do { int f_ = 0; _Pragma("unroll") for (int q_ = 1; q_ < 6; ++q_) if ((it_) >= F[q_].first) f_ = q_; \
        TrFam G_ = F[0]; _Pragma("unroll") for (int q_ = 1; q_ < 6; ++q_) if (f_ == q_) G_ = F[q_]; tr_decode(G_, (it_), src, dst, d0, d1, Nn, ldk); } while (0)
#define TR_LOAD(v_) do { const float* p_ = src + (size_t)(16 * w) * Nn + 4 * lane; _Pragma("unroll") for (int i = 0; i < 16; ++i) v_[i] = __builtin_nontemporal_load((const f32x4*)(p_ + (size_t)i * Nn)); } while (0)
#define TR_EMIT(v_, dst_, d0_, d1_, ld_, par_) do { LAS unsigned* Tl = (LAS unsigned*)(C.lds + (par_) * 67584); \
        _Pragma("unroll") for (int j = 0; j < 8; ++j) _Pragma("unroll") for (int c = 0; c < 4; ++c) Tl[(4 * lane + c) * 65 + ((8 * w + j) ^ ((lane >> 3) & 3))] = pk2(v_[2 * j][c], v_[2 * j + 1][c]); } while (0)
#define TR_STORE(dst_, d0_, d1_, ld_, par_) do { const LAS unsigned* Tl = (const LAS unsigned*)(C.lds + (par_) * 67584); const int kc = lane & 15, nr = lane >> 4; \
        _Pragma("unroll") for (int q = 0; q < 8; ++q) { const int n = 32 * w + 4 * q + nr; const LAS unsigned* tp = Tl + n * 65 + 4 * kc; \
            const int sw_ = w & 3; u32x4 o; o.x = tp[0 ^ sw_]; o.y = tp[1 ^ sw_]; o.z = tp[2 ^ sw_]; o.w = tp[3 ^ sw_]; const int drow = (n < 128 ? (d0_) : (d1_) - 128) + n; \
            *(u32x4*)((dst_) + (size_t)drow * (ld_) + 8 * kc) = o; } } while (0)
#pragma unroll
    for (int i = 0; i < 16; ++i) { va[i] = (f32x4){0.f, 0.f, 0.f, 0.f}; vb[i] = va[i]; }
    int it = bi;
    if (it < tot) { TR_FIND(it); TR_LOAD(va); dstA = dst; d0A = d0; d1A = d1; ldA = ldk; }
    if (it + nbk < tot) { TR_FIND(it + nbk); TR_LOAD(vb); dstB = dst; d0B = d0; d1B = d1; ldB = ldk; }
    while (it < tot) {
        TR_EMIT(va, dstA, d0A, d1A, ldA, 0);
        bf16_t* cd = dstA; const int c0 = d0A, c1 = d1A, cl = ldA;
        if (it + 2 * nbk < tot) { TR_FIND(it + 2 * nbk); TR_LOAD(va); dstA = dst; d0A = d0; d1A = d1; ldA = ldk; }
        __syncthreads();
        TR_STORE(cd, c0, c1, cl, 0);
        it += nbk; if (it >= tot) break;
        TR_EMIT(vb, dstB, d0B, d1B, ldB, 1);
        cd = dstB; const int e0 = d0B, e1 = d1B, el = ldB;
        if (it + 2 * nbk < tot) { TR_FIND(it + 2 * nbk); TR_LOAD(vb); dstB = dst; d0B = d0; d1B = d1; ldB = ldk; }
        __syncthreads();
        TR_STORE(cd, e0, e1, el, 1);
        it += nbk;
    }
    __syncthreads();
#undef TR_FIND
#undef TR_EMIT
#undef TR_STORE
#undef TR_LOAD
}
__device__ __forceinline__ void phase0(Ctx& C) {
    PHASE_BEGIN(C);

    phase0_transposes(C, 0, 0, C.bid, C.nb);
    { float* mod = WSP(float, WS_MOD); const float* c = INP(1); const float* cc = INP(3); const float* wm = INP(4); const float* bm = INP(5);
      LAS float* red = (LAS float*)(C.lds + 8 * 16384);
      red = (LAS float*)(C.lds + 131072);
      for (int item = C.bid; item < 2 * 192; item += C.nb) {
          const int l = item / 192, j = (item % 192) * 32 + (C.tid & 31), kc = C.tid >> 5;
          float a0 = 0.f, a1 = 0.f, a2 = 0.f, a3 = 0.f, a4 = 0.f;
#pragma unroll 8
          for (int k = kc * 64; k < kc * 64 + 64; ++k) {
              const float w = wm[((size_t)l * D + k) * 6144 + j];
              const float x0 = c[k], x1 = c[D + k], x2 = c[2 * D + k], x3 = c[3 * D + k], x4 = cc[k];
              a0 += x0 * sigmoidf_(x0) * w; a1 += x1 * sigmoidf_(x1) * w; a2 += x2 * sigmoidf_(x2) * w; a3 += x3 * sigmoidf_(x3) * w; a4 += x4 * sigmoidf_(x4) * w;
          }
          __syncthreads();
          red[(0 * 16 + kc) * 32 + (C.tid & 31)] = a0; red[(1 * 16 + kc) * 32 + (C.tid & 31)] = a1; red[(2 * 16 + kc) * 32 + (C.tid & 31)] = a2;
          red[(3 * 16 + kc) * 32 + (C.tid & 31)] = a3; red[(4 * 16 + kc) * 32 + (C.tid & 31)] = a4;
          __syncthreads();
          if (C.tid < 160) { const int r = C.tid >> 5, jj = C.tid & 31; float sacc = bm[l * 6144 + (item % 192) * 32 + jj];
              for (int q = 0; q < 16; ++q) sacc += red[(r * 16 + q) * 32 + jj];
              mod[((size_t)l * 5 + r) * 6144 + (item % 192) * 32 + jj] = sacc; }
      } }
    { f32x2* rope = WSP(f32x2, WS_ROPE);
      for (size_t it = C.gtid; it < 64 * 16; it += C.gthr) { const int pos = (int)(it >> 4), i = (int)(it & 15); const float inv = powf(10000.0f, -(float)i / 16.0f); const float ang = (float)pos * inv; rope[it] = (f32x2){cosf(ang), sinf(ang)}; } }
}
__device__ __forceinline__ void ln_stats(f32x4 (&v)[4], float& mean, float& rstd, int lane) {
    float s = 0.f;
#pragma unroll
    for (int j = 0; j < 4; ++j) s += (v[j].x + v[j].y) + (v[j].z + v[j].w);
    mean = wave_sum(s, lane) * (1.f / D); float s2 = 0.f;
#pragma unroll
    for (int j = 0; j < 4; ++j) { const f32x4 d = v[j] - mean; s2 += (d.x * d.x + d.y * d.y) + (d.z * d.z + d.w * d.w); }
    rstd = __builtin_amdgcn_rsqf(wave_sum(s2, lane) * (1.f / D) + LN_EPS);
}
__device__ __forceinline__ void phase_ln0(Ctx& C, int l) {
    PHASE_BEGIN(C); PIN_S(l);
    const float* hx = INP(0); const float* hcx = INP(2) - (size_t)NLAT * D; bf16_t* U = WSP(bf16_t, WS_U); const float* mod = WSP(float, WS_MOD) + (size_t)l * 5 * 6144;
    for (int row = C.gw; row < T; row += C.ngw) {
        const f32x4* xr = (const f32x4*)((row < NLAT ? hx : hcx) + (size_t)row * D) + C.lane; f32x4 v[4];
#pragma unroll
        for (int j = 0; j < 4; ++j) v[j] = xr[64 * j];
        float mean, rstd; ln_stats(v, mean, rstd, C.lane);
        const int r = row < NLAT ? (row >> 12) : 4; const f32x4* sh = (const f32x4*)(mod + r * 6144) + C.lane; const f32x4* sc = (const f32x4*)(mod + r * 6144 + D) + C.lane;
        u32x2* o = (u32x2*)(U + (size_t)row * D) + C.lane;
#pragma unroll
        for (int j = 0; j < 4; ++j) { const f32x4 y = (v[j] - mean) * rstd * (sc[64 * j] + 1.0f) + sh[64 * j]; u32x2 w; w.x = pk2(y.x, y.y); w.y = pk2(y.z, y.w); o[64 * j] = w; }
    }
}
__device__ __forceinline__ bool nb_valid(int row, int d) {
    if (row < NLAT) { const int s = (row & (SEQ - 1)) + d; return s >= 0 && s < SEQ; }
    const int i = ((row - NLAT) & (CTX - 1)) + d; return i >= 0 && i < CTX;
}
__device__ __forceinline__ void conv_chunk(Ctx& C, const bf16_t* P, bf16_t* SC, const float* scw, int chunk) {
#pragma unroll 2
    for (int u = 0; u < 4; ++u) {
        const int it = chunk * 2048 + C.tid + 512 * u; const int row = it >> 6, c0 = (it & 63) * 8;
        float acc[8], sb[8];
#pragma unroll
        for (int e = 0; e < 8; ++e) acc[e] = 0.f;
#pragma unroll
        for (int k = 0; k < 3; ++k) { const int d = k - 1; if (nb_valid(row, d)) { float g[8], x[8]; unpack8(*(const u32x4*)(P + (size_t)(row + d) * PT + C_SCG + c0), g); unpack8(*(const u32x4*)(P + (size_t)(row + d) * PT + C_SX + c0), x);
#pragma unroll
                for (int e = 0; e < 8; ++e) acc[e] += scw[k * 512 + c0 + e] * (g[e] * x[e]); } }
        unpack8(*(const u32x4*)(P + (size_t)row * PT + C_SB + c0), sb);
#pragma unroll
        for (int e = 0; e < 8; ++e) acc[e] *= sb[e];
        *(u32x4*)(SC + (size_t)row * 2048 + c0) = pack8(acc);
    }
}
constexpr int A3_CK = 0, A3_CV = 32768, A3_LK = 66560, A3_RP = 133120, A3_MG = 135168, A3_QS = 152064, A3_CVS = 528, A3_LVS = 1040;
__device__ __forceinline__ int a3_f(int kk) { return (((kk >> 3) & 3) << 1) | ((kk >> 1) & 1); }
template <bool LOCAL>
__device__ __forceinline__ void attn_item(Ctx& C, const bf16_t* P, const bf16_t* VT, bf16_t* O, const float* rpb_l, int b, int hd, int r, int qrow_base, int* ctr, LAS int* qslot) {
    int nxq = 0; if (C.tid == 0) nxq = atomicAdd(ctr, 1);
    const int tid = C.tid, lane = C.lane, w = C.wave, grp = w & 3, kh = w >> 2;
    const int q = lane & 15, g = lane >> 4, i = lane & 15;
    const int r0 = LOCAL ? min(max(r - 4, 0), 56) : 0; const int w0 = LOCAL ? (grp == 0 ? 0 : grp == 1 ? 8 : grp == 2 ? 24 : 32) : 0;
    LAS unsigned char* L = C.lds;
    constexpr int NA = LOCAL ? 12 : 4;
    u32x4 st[NA];
#pragma unroll
    for (int u = 0; u < 4; ++u) { const int p = tid + 512 * u, k = p >> 3, c = (p & 7) ^ a3_f(k); st[u] = *(const u32x4*)(P + (size_t)(NLAT + b * CTX + k) * PT + C_K + hd * 64 + 8 * c); }
    if (LOCAL) {
#pragma unroll
        for (int u = 0; u < 8; ++u) { const int p = tid + 512 * u, kk = p >> 3, c = (p & 7) ^ a3_f(kk); const int row = b * SEQ + (r0 + (kk >> 6)) * 64 + (kk & 63);
            st[4 + u] = *(const u32x4*)(P + (size_t)row * PT + C_K + hd * 64 + 8 * c); } }
    float rpv = 0.f; if (LOCAL && tid < 465) rpv = rpb_l[hd * 465 + tid];
    const int qrow0 = qrow_base + 16 * grp;
    bf16x8 Qf[2];
#pragma unroll
    for (int ks = 0; ks < 2; ++ks) { float t8[8]; unpack8(*(const u32x4*)(P + (size_t)(qrow0 + q) * PT + C_Q + hd * 64 + 32 * ks + 8 * g), t8);
#pragma unroll
        for (int j = 0; j < 8; ++j) t8[j] *= 0.125f;
        Qf[ks] = __builtin_bit_cast(bf16x8, pack8(t8)); }
#pragma unroll
    for (int u = 0; u < 4; ++u) *(LAS u32x4*)(L + A3_CK + (tid + 512 * u) * 16) = st[u];
    if (LOCAL) {
#pragma unroll
        for (int u = 0; u < 8; ++u) *(LAS u32x4*)(L + A3_LK + (tid + 512 * u) * 16) = st[4 + u];
        if (tid < 465) ((LAS float*)(L + A3_RP))[tid] = rpv; }
    __syncthreads();
#pragma unroll
    for (int u = 0; u < 4; ++u) { const int p = tid + 512 * u, dh = p >> 5, ch = p & 31; st[u] = *(const u32x4*)(VT + (size_t)(hd * 64 + dh) * T + NLAT + b * CTX + 8 * ch); }
    if (LOCAL) {
#pragma unroll
        for (int u = 0; u < 8; ++u) { const int p = tid + 512 * u, dh = p >> 6, ch = p & 63; const int tok = b * SEQ + (r0 + (ch >> 3)) * 64 + 8 * (ch & 7);
            st[4 + u] = *(const u32x4*)(VT + (size_t)(hd * 64 + dh) * T + tok); } }
    constexpr int NT = LOCAL ? 16 : 8;
    f32x4 S[NT];
    const int koff = 8 * (i >> 2) + (i & 3);
#pragma unroll
    for (int j = 0; j < 4; ++j)
#pragma unroll
        for (int tt = 0; tt < 2; ++tt) { const int kk = 128 * kh + 32 * j + koff + 4 * tt, fs = a3_f(kk); const LAS unsigned char* kb = L + A3_CK + kk * 128;
            f32x4 a = (f32x4){0.f, 0.f, 0.f, 0.f};
            a = __builtin_amdgcn_mfma_f32_16x16x32_bf16(*(const LAS bf16x8*)(kb + ((g ^ fs) << 4)), Qf[0], a, 0, 0, 0);
            a = __builtin_amdgcn_mfma_f32_16x16x32_bf16(*(const LAS bf16x8*)(kb + (((g + 4) ^ fs) << 4)), Qf[1], a, 0, 0, 0);
            S[2 * j + tt] = a; }
    if (LOCAL) {
#pragma unroll
        for (int j = 0; j < 4; ++j)
#pragma unroll
            for (int tt = 0; tt < 2; ++tt) { const int kk = (4 * kh + j) * 64 + w0 + koff + 4 * tt, fs = a3_f(kk); const LAS unsigned char* kb = L + A3_LK + kk * 128;
                f32x4 a = (f32x4){0.f, 0.f, 0.f, 0.f};
                a = __builtin_amdgcn_mfma_f32_16x16x32_bf16(*(const LAS bf16x8*)(kb + ((g ^ fs) << 4)), Qf[0], a, 0, 0, 0);
                a = __builtin_amdgcn_mfma_f32_16x16x32_bf16(*(const LAS bf16x8*)(kb + (((g + 4) ^ fs) << 4)), Qf[1], a, 0, 0, 0);
                S[8 + 2 * j + tt] = a; }
        const int c = 16 * grp + q, cs = min(max(c - 8, 0), 48);
        const int vb = w0 + 8 * g - cs;
        const LAS float* bp = (const LAS float*)(L + A3_RP) + (r0 - r + 7 + 4 * kh) * 31 + (w0 + 8 * g - c + 15);
#pragma unroll
        for (int j = 0; j < 4; ++j)
#pragma unroll
            for (int tt = 0; tt < 2; ++tt)
#pragma unroll
                for (int rg = 0; rg < 4; ++rg) { const bool ok = (unsigned)(vb + rg + 4 * tt) < 16u; const float v = S[8 + 2 * j + tt][rg] + bp[j * 31 + rg + 4 * tt];
                    S[8 + 2 * j + tt][rg] = ok ? v : -1e30f; }
    }
    float mx = -1e30f;
#pragma unroll
    for (int t = 0; t < NT; ++t) mx = fmaxf(fmaxf(mx, fmaxf(S[t][0], S[t][1])), fmaxf(S[t][2], S[t][3]));
    mx = fmaxf(mx, bperm(lane ^ 16, mx)); mx = fmaxf(mx, bperm(lane ^ 32, mx));
    float ls = 0.f;
#pragma unroll
    for (int t = 0; t < NT; ++t)
#pragma unroll
        for (int rg = 0; rg < 4; ++rg) { const float pe = __expf(S[t][rg] - mx); S[t][rg] = pe; ls += pe; }
    ls += bperm(lane ^ 16, ls); ls += bperm(lane ^ 32, ls);
    __syncthreads();
    if (tid == 0) *qslot = nxq;
#pragma unroll
    for (int u = 0; u < 4; ++u) { const int p = tid + 512 * u; *(LAS u32x4*)(L + A3_CV + (p >> 5) * A3_CVS + (p & 31) * 16) = st[u]; }
    if (LOCAL) {
#pragma unroll
        for (int u = 0; u < 8; ++u) { const int p = tid + 512 * u; *(LAS u32x4*)(L + A3_LK + (p >> 6) * A3_LVS + (p & 63) * 16) = st[4 + u]; } }
    __syncthreads();
    f32x4 Oa[4];
#pragma unroll
    for (int dt = 0; dt < 4; ++dt) Oa[dt] = (f32x4){0.f, 0.f, 0.f, 0.f};
#pragma unroll
    for (int j = 0; j < 4; ++j) {
        float p8[8] = {S[2 * j][0], S[2 * j][1], S[2 * j][2], S[2 * j][3], S[2 * j + 1][0], S[2 * j + 1][1], S[2 * j + 1][2], S[2 * j + 1][3]};
        const bf16x8 pk = __builtin_bit_cast(bf16x8, pack8(p8));
#pragma unroll
        for (int dt = 0; dt < 4; ++dt) Oa[dt] = __builtin_amdgcn_mfma_f32_16x16x32_bf16(*(const LAS bf16x8*)(L + A3_CV + (16 * dt + i) * A3_CVS + (128 * kh + 32 * j + 8 * g) * 2), pk, Oa[dt], 0, 0, 0);
    }
    if (LOCAL) {
#pragma unroll
        for (int j = 0; j < 4; ++j) {
            float p8[8] = {S[8 + 2 * j][0], S[8 + 2 * j][1], S[8 + 2 * j][2], S[8 + 2 * j][3], S[9 + 2 * j][0], S[9 + 2 * j][1], S[9 + 2 * j][2], S[9 + 2 * j][3]};
            const bf16x8 pk = __builtin_bit_cast(bf16x8, pack8(p8));
#pragma unroll
            for (int dt = 0; dt < 4; ++dt) Oa[dt] = __builtin_amdgcn_mfma_f32_16x16x32_bf16(*(const LAS bf16x8*)(L + A3_LK + (16 * dt + i) * A3_LVS + ((4 * kh + j) * 64 + w0 + 8 * g) * 2), pk, Oa[dt], 0, 0, 0);
        }
    }
    LAS unsigned char* MG = L + A3_MG + grp * 4224;
    if (kh == 1) {
#pragma unroll
        for (int dt = 0; dt < 4; ++dt) *(LAS f32x4*)(MG + (q * 64 + 16 * dt + 4 * g) * 4) = Oa[dt];
        if (g == 0) { ((LAS float*)(MG + 4096))[2 * q] = mx; ((LAS float*)(MG + 4096))[2 * q + 1] = ls; } }
    __syncthreads();
    if (kh == 0) {
        const float m1 = ((const LAS float*)(MG + 4096))[2 * q], l1 = ((const LAS float*)(MG + 4096))[2 * q + 1];
        const float m = fmaxf(mx, m1), f0 = __expf(mx - m), f1 = __expf(m1 - m); const float inv = 1.0f / (ls * f0 + l1 * f1);
#pragma unroll
        for (int dt = 0; dt < 4; ++dt) { const f32x4 o1 = *(const LAS f32x4*)(MG + (q * 64 + 16 * dt + 4 * g) * 4); const f32x4 o = (Oa[dt] * f0 + o1 * f1) * inv;
            u32x2 wv; wv.x = pk2(o[0], o[1]); wv.y = pk2(o[2], o[3]);
            *(u32x2*)(O + (size_t)(qrow0 + q) * 2048 + hd * 64 + 16 * dt + 4 * g) = wv; } }
}
__device__ __forceinline__ void phase_attn3(Ctx& C, int l, bool with_ctx) {
    PHASE_BEGIN(C); PIN_S(l);
    const bf16_t* P = WSP(bf16_t, WS_P); const bf16_t* VT = WSP(bf16_t, WS_VT); bf16_t* O = WSP(bf16_t, WS_CAT); const float* rpb = INP(8) + (size_t)l * 8 * 465;
    LAS int* qslot = (LAS int*)(C.lds + A3_QS);
    const int xcd = C.bid & 7; int* ctr = WSP(int, WS_CTL) + 128 + l * 8 + xcd;
    const int nper = 256 + (with_ctx ? 16 : 0);
    const int nconv = ((l == 1 ? NLAT : T) / 32) / 8;
    bf16_t* SC = WSP(bf16_t, WS_CAT) + 512; const float* scw = INP(12) + (size_t)l * 3 * 512;
    __syncthreads();
    if (C.tid == 0) *qslot = atomicAdd(ctr, 1);
    for (;;) {
        __syncthreads();
        const int j = *qslot; if (j >= nper + nconv) break;
        if (j >= nper) { int nxq = 0; if (C.tid == 0) nxq = atomicAdd(ctr, 1);
            conv_chunk(C, P, SC, scw, (j - nper) * 8 + xcd);
            __syncthreads(); if (C.tid == 0) *qslot = nxq; continue; }
        if (j < 256) { const int rr = 32 * xcd + (j >> 3), hd = j & 7; const int b = rr >> 6, r = rr & 63;
            attn_item<true>(C, P, VT, O, rpb, b, hd, r, b * SEQ + r * 64, ctr, qslot); }
        else { const int cidx = 16 * xcd + (j - 256); const int b = cidx >> 5, hd = (cidx >> 2) & 7, ch = cidx & 3;
            attn_item<false>(C, P, VT, O, rpb, b, hd, 0, NLAT + b * CTX + 64 * ch, ctr, qslot); }
    }
}
typedef float f32x16 __attribute__((ext_vector_type(16)));
__device__ __forceinline__ int lru_row(int b, int d, int p) {
    if (p < CTX) return NLAT + b * CTX + (d ? CTX - 1 - p : p);
    const int s = p - CTX; return b * SEQ + (d ? SEQ - 1 - s : s);
}
__device__ __forceinline__ float fsigmoid(float x) { return __builtin_amdgcn_rcpf(1.0f + __expf(-x)); }
__device__ __forceinline__ void phase_lru(Ctx& C, int l) {
    PHASE_BEGIN(C); PIN_S(l);
    const bf16_t* P = WSP(bf16_t, WS_P); bf16_t* LR = WSP(bf16_t, WS_CAT) + 1024;
    const float* lcw = INP(13) + (size_t)l * 4 * 512; const float* lcb = INP(14) + (size_t)l * 512; const float* lam = INP(15) + (size_t)l * 2 * 512;
    const float* wr_ = INP(16) + (size_t)l * 2 * 8 * 4096; const float* br = INP(17) + (size_t)l * 2 * 512;
    const float* wi_ = INP(18) + (size_t)l * 2 * 8 * 4096; const float* bi = INP(19) + (size_t)l * 2 * 512;
    LAS float* cw = (LAS float*)C.lds;
    LAS f32x2* agg = (LAS f32x2*)(C.lds + 2048);
    const int lane = C.lane, w = C.wave, col = lane & 31, hi = lane >> 5;
    LAS unsigned char* Llx = C.lds + 8192 + w * 10240; LAS unsigned char* Llg = Llx + 5120; LAS unsigned char* Lout = Llx + 7680;
    for (int item = C.bid; item < 128; item += C.nb) {
        const int b = item >> 5, d = (item >> 4) & 1, n = (item >> 1) & 7, half = item & 1;
        __syncthreads();
        if (C.tid < 320) cw[C.tid] = C.tid < 256 ? lcw[(C.tid >> 6) * 512 + n * 64 + (C.tid & 63)] : lcb[n * 64 + (C.tid - 256)];
        __syncthreads();
        const int e = n * 64 + half * 32 + col;
        bf16x8 Br[4], Bi[4], Bid[2];
#pragma unroll
        for (int ks = 0; ks < 4; ++ks) { float vr[8], vi[8];
#pragma unroll
            for (int j = 0; j < 8; ++j) { const size_t o = ((size_t)(d * 8 + n) * 64 + 16 * ks + 8 * hi + j) * 64 + half * 32 + col; vr[j] = wr_[o]; vi[j] = wi_[o]; }
            Br[ks] = __builtin_bit_cast(bf16x8, pack8(vr)); Bi[ks] = __builtin_bit_cast(bf16x8, pack8(vi)); }
#pragma unroll
        for (int q = 0; q < 2; ++q) { float v1[8];
#pragma unroll
            for (int j = 0; j < 8; ++j) v1[j] = (16 * q + 8 * hi + j == col) ? 1.0f : 0.0f;
            Bid[q] = __builtin_bit_cast(bf16x8, pack8(v1)); }
        const float cl2 = -8.0f * log1pf(expf(-lam[d * 512 + e])) * 1.4426950408889634f;
        const float brv = br[d * 512 + e], biv = bi[d * 512 + e];
#define LRU_RLO(sc_) ((sc_) == 0 ? NLAT + b * CTX + (d ? 224 - w * 32 : w * 32) : b * SEQ + (d ? 4064 - (((sc_) - 1) * 256 + w * 32) : ((sc_) - 1) * 256 + w * 32))
#define LRU_LOAD(sc_) do { const int rlo_ = LRU_RLO(sc_); const int slo_ = (sc_) == 0 ? NLAT + b * CTX : b * SEQ, shi_ = (sc_) == 0 ? slo_ + CTX : slo_ + SEQ; \
        _Pragma("unroll") for (int u = 0; u < 5; ++u) { const int q_ = lane + 64 * u; const int t_ = q_ >> 3; const int row_ = rlo_ - 2 + t_; const bool ok_ = (q_ < 280) && row_ >= slo_ && row_ < shi_; \
            const int rc_ = ok_ ? row_ : rlo_; const u32x4 v_ = *(const u32x4*)(P + (size_t)rc_ * PT + C_LX + n * 64 + 8 * (q_ & 7)); lxr[u] = ok_ ? v_ : (u32x4){0u, 0u, 0u, 0u}; } \
        _Pragma("unroll") for (int u = 0; u < 2; ++u) { const int q_ = lane + 64 * u; lgr[u] = *(const u32x4*)(P + (size_t)(rlo_ + (q_ >> 2)) * PT + C_LG + n * 64 + half * 32 + 8 * (q_ & 3)); } } while (0)
        u32x4 lxr[5], lgr[2];
        LRU_LOAD(0);
        float run = 0.f;
#pragma unroll 1
        for (int sc = 0; sc < 17; ++sc) {
            const int rlo = LRU_RLO(sc);
#pragma unroll
            for (int u = 0; u < 5; ++u) { const int q_ = lane + 64 * u; if (q_ < 280) *(LAS u32x4*)(Llx + (q_ >> 3) * 144 + (q_ & 7) * 16) = lxr[u]; }
#pragma unroll
            for (int u = 0; u < 2; ++u) { const int q_ = lane + 64 * u; *(LAS u32x4*)(Llg + (q_ >> 2) * 80 + (q_ & 3) * 16) = lgr[u]; }
            if (sc + 1 < 17) LRU_LOAD(sc + 1);
            const int pa = 16 * ((col >> 2) & 1) + 4 * (col >> 3) + (col & 3);
            const int rho = d ? 31 - pa : pa;
            bf16x8 A[4];
#pragma unroll
            for (int ks = 0; ks < 4; ++ks) { const int k0 = 16 * ks + 8 * hi; float x[8];
#pragma unroll
                for (int j = 0; j < 8; ++j) x[j] = cw[256 + k0 + j];
#pragma unroll
                for (int tap = 0; tap < 4; ++tap) { float v8[8]; unpack8(*(const LAS u32x4*)(Llx + (rho + tap) * 144 + (2 * ks + hi) * 16), v8);
#pragma unroll
                    for (int j = 0; j < 8; ++j) x[j] += cw[tap * 64 + k0 + j] * v8[j]; }
                A[ks] = __builtin_bit_cast(bf16x8, pack8(x)); }
            f32x16 aR, aI, aX;
#pragma unroll
            for (int r = 0; r < 16; ++r) { aR[r] = brv; aI[r] = biv; aX[r] = 0.f; }
#pragma unroll
            for (int ks = 0; ks < 4; ++ks) { aR = __builtin_amdgcn_mfma_f32_32x32x16_bf16(A[ks], Br[ks], aR, 0, 0, 0); aI = __builtin_amdgcn_mfma_f32_32x32x16_bf16(A[ks], Bi[ks], aI, 0, 0, 0); }
            { const bf16x8 Ax0 = half ? A[2] : A[0], Ax1 = half ? A[3] : A[1];
              aX = __builtin_amdgcn_mfma_f32_32x32x16_bf16(Ax0, Bid[0], aX, 0, 0, 0); aX = __builtin_amdgcn_mfma_f32_32x32x16_bf16(Ax1, Bid[1], aX, 0, 0, 0); }
            float hl[16], ac[16]; float h = 0.f, Ac = 1.f;
#pragma unroll
            for (int r = 0; r < 16; ++r) {
                const float rr = fsigmoid(aR[r]), ig = fsigmoid(aI[r]); const float la2 = cl2 * rr; const float a = __builtin_amdgcn_exp2f(la2);
                const float x2 = la2 * 1.3862943611198906f;
                const float poly = -x2 * (1.0f + x2 * (0.5f + x2 * (0.16666667f + x2 * (0.041666668f + x2 * (0.0083333338f + x2 * 0.0013888889f)))));
                const float em = x2 > -0.3f ? poly : 1.0f - a * a;
                const float bb = __builtin_amdgcn_sqrtf(em) * (ig * aX[r]);
                h = a * h + bb; Ac *= a; hl[r] = h; ac[r] = Ac;
            }
            const float A0 = bperm(col, Ac), h0 = bperm(col, h), A1 = bperm(col + 32, Ac), h1 = bperm(col + 32, h);
            const int par = sc & 1;
            if (hi == 0) agg[(par * 8 + w) * 32 + col] = (f32x2){A0 * A1, h1 + A1 * h0};
            __syncthreads();
            float carry = run, cin = 0.f;
#pragma unroll
            for (int ww = 0; ww < 8; ++ww) { const f32x2 g = agg[(par * 8 + ww) * 32 + col]; if (ww == w) cin = carry; carry = g.y + g.x * carry; }
            run = carry;
            const float cl = hi ? (h0 + A0 * cin) : cin;
#pragma unroll
            for (int r = 0; r < 16; ++r) { const int rr_ = d ? 31 - (16 * hi + r) : 16 * hi + r;
                const float lgv = bf2f(*(const LAS unsigned short*)(Llg + rr_ * 80 + col * 2)); const float hf = hl[r] + ac[r] * cl;
                const float u = 0.7978845608028654f * (lgv + 0.044715f * lgv * lgv * lgv);
                *(LAS unsigned short*)(Lout + rr_ * 80 + col * 2) = (unsigned short)f2bf(lgv * fsigmoid(2.0f * u) * hf); }
#pragma unroll
            for (int u = 0; u < 2; ++u) { const int q_ = lane + 64 * u; const u32x4 o = *(const LAS u32x4*)(Lout + (q_ >> 2) * 80 + (q_ & 3) * 16);
                *(u32x4*)(LR + (size_t)(rlo + (q_ >> 2)) * 2048 + d * 512 + n * 64 + half * 32 + 8 * (q_ & 3)) = o; }
        }
#undef LRU_RLO
#undef LRU_LOAD
    }
}
__device__ __forceinline__ void phase_ln1(Ctx& C, int l, int nrows) {
    PHASE_BEGIN(C); PIN_S(l);
    const bf16_t* V = WSP(bf16_t, WS_V); float* H = WSP(float, WS_H); bf16_t* U = WSP(bf16_t, WS_U); const float* mod = WSP(float, WS_MOD) + (size_t)l * 5 * 6144;
    const float* g1 = INP(22) + l * D; const float* b1 = INP(23) + l * D; const float* rw = INP(24) + (size_t)l * D * 32; const float* rb = INP(25) + l * 32;
    int* topi = WSP(int, WS_SMALL); float* topp = WSP(float, WS_SMALL + 512 * 1024); int* cnt = WSP(int, WS_CTL) + 1024 + l * 1024;
    int* epos = WSP(int, WS_SMALL + 1 * MiB); int* etok = WSP(int, WS_ETOK) + (size_t)l * 32 * ECAP;
    LAS float* Ut = (LAS float*)C.lds;
    LAS float* Pt = (LAS float*)(C.lds + 65792);
    LAS float* Lg = (LAS float*)(C.lds + 65792 + 16384);
    LAS int* lcnt = (LAS int*)(C.lds + LDS_LN1); LAS int* lbase = lcnt + 32; LAS int* rec = lcnt + 64;
    __syncthreads();
    if (C.tid < 32) lcnt[C.tid] = 0;
    const int lane = C.lane, w = C.wave, e = lane & 31, hr = lane >> 5;
    float Bf[32][2];
#pragma unroll
    for (int s_ = 0; s_ < 32; ++s_)
#pragma unroll
        for (int t = 0; t < 2; ++t) Bf[s_][t] = rw[(size_t)(128 * w + 4 * s_ + (lane >> 4)) * 32 + 16 * t + (lane & 15)];
    const float rbe = rb[e];
    const int nbatch = nrows / 16;
    f32x4 vn[2][4];
#define LN1_LOADV(q_, row_) do { _Pragma("unroll") for (int j = 0; j < 4; ++j) { const u32x2 w_ = ((const u32x2*)(V + (size_t)(row_) * D) + lane)[64 * j]; \
        vn[q_][j] = (f32x4){bf2f(w_.x & 0xffffu), bf2f(w_.x >> 16), bf2f(w_.y & 0xffffu), bf2f(w_.y >> 16)}; } } while (0)
#pragma unroll
    for (int q = 0; q < 2; ++q)
#pragma unroll
        for (int j = 0; j < 4; ++j) vn[q][j] = (f32x4){0.f, 0.f, 0.f, 0.f};
    int bt = C.bid, ri = 0;
    if (bt < nbatch) { LN1_LOADV(0, bt * 16 + 2 * w); LN1_LOADV(1, bt * 16 + 2 * w + 1); }
    while (bt < nbatch) {
        const int nbt = bt + C.nb;
#pragma unroll
        for (int q = 0; q < 2; ++q) {
            const int row = bt * 16 + 2 * w + q;
            f32x4 v[4];
#pragma unroll
            for (int j = 0; j < 4; ++j) v[j] = vn[q][j];
            if (nbt < nbatch) { LN1_LOADV(q, nbt * 16 + 2 * w + q); }
            float mean, rstd; ln_stats(v, mean, rstd, lane);
#pragma unroll
            for (int j = 0; j < 4; ++j) v[j] = (v[j] - mean) * rstd * ((const f32x4*)g1)[lane + 64 * j] + ((const f32x4*)b1)[lane + 64 * j];
            ln_stats(v, mean, rstd, lane);
            const int r = row < NLAT ? (row >> 12) : 4; const f32x4* sh = (const f32x4*)(mod + r * 6144 + 3 * D) + lane; const f32x4* sc = (const f32x4*)(mod + r * 6144 + 4 * D) + lane;
            u32x2* o = (u32x2*)(U + (size_t)row * D) + lane;
#pragma unroll
            for (int j = 0; j < 4; ++j) { v[j] = (v[j] - mean) * rstd * (sc[64 * j] + 1.0f) + sh[64 * j]; u32x2 wv; wv.x = pk2(v[j].x, v[j].y); wv.y = pk2(v[j].z, v[j].w); o[64 * j] = wv;
                *(LAS f32x4*)(Ut + (2 * w + q) * 1028 + 4 * lane + 256 * j) = v[j]; }
        }
        __syncthreads();
        { f32x4 a0 = (f32x4){0.f, 0.f, 0.f, 0.f}, a1 = a0;
          const LAS float* ap = Ut + (lane & 15) * 1028 + 128 * w + (lane >> 4);
#pragma unroll
          for (int s_ = 0; s_ < 32; ++s_) { const float av = ap[4 * s_];
              a0 = __builtin_amdgcn_mfma_f32_16x16x4f32(av, Bf[s_][0], a0, 0, 0, 0); a1 = __builtin_amdgcn_mfma_f32_16x16x4f32(av, Bf[s_][1], a1, 0, 0, 0); }
          LAS float* pp = Pt + (w * 16 + 4 * (lane >> 4)) * 32 + (lane & 15);
#pragma unroll
          for (int rg = 0; rg < 4; ++rg) { pp[rg * 32] = a0[rg]; pp[rg * 32 + 16] = a1[rg]; } }
        __syncthreads();
        { const int q = 2 * w + hr, row = bt * 16 + q;
          float acc = rbe;
#pragma unroll
          for (int ww = 0; ww < 8; ++ww) acc += Pt[(ww * 16 + q) * 32 + e];
          Lg[q * 32 + e] = acc;
          asm volatile("s_waitcnt lgkmcnt(0)" ::: "memory");
          int rank = 0;
#pragma unroll
          for (int g = 0; g < 8; ++g) { const f32x4 lq = *(const LAS f32x4*)(Lg + q * 32 + 4 * g);
#pragma unroll
              for (int j = 0; j < 4; ++j) rank += (lq[j] > acc || (lq[j] == acc && 4 * g + j < e)) ? 1 : 0; }
          const bool sel = rank < 4;
          const float t0c = (rank == 0) ? acc : -3.0e38f;
          float t0 = t0c;
#pragma unroll
          for (int o_ = 1; o_ < 32; o_ <<= 1) t0 = fmaxf(t0, bperm(lane ^ o_, t0));
          const float pe = sel ? __expf(acc - t0) : 0.f;
          float psum = pe;
#pragma unroll
          for (int o_ = 1; o_ < 32; o_ <<= 1) psum += bperm(lane ^ o_, psum);
          if (sel) {
              topi[(size_t)row * 4 + rank] = e; topp[(size_t)row * 4 + rank] = pe * __builtin_amdgcn_rcpf(psum);
              const int lpos = __hip_atomic_fetch_add(lcnt + e, 1, __ATOMIC_RELAXED, __HIP_MEMORY_SCOPE_WORKGROUP);
              rec[((w * 2 + hr) * 8 + ri) * 4 + rank] = (e << 16) | lpos;
          } }
        ++ri; bt = nbt;
    }
#undef LN1_LOADV
    __syncthreads();
    if (C.tid < 32) lbase[C.tid] = atomicAdd(cnt + 32 * C.tid, lcnt[C.tid]);
    __syncthreads();
    if ((lane & 31) < 4) { const int k = lane & 31; int bt2 = C.bid;
        for (int i = 0; i < ri; ++i, bt2 += C.nb) { const int row = bt2 * 16 + 2 * w + hr; const int rr = rec[((w * 2 + hr) * 8 + i) * 4 + k]; const int ek = rr >> 16, pos = lbase[ek] + (rr & 0xffff);
            etok[(size_t)ek * ECAP + pos] = row; epos[(size_t)row * 4 + k] = pos; } }
}
__device__ __forceinline__ void build_blk(Ctx& C, int l) {
    LAS int* blk = (LAS int*)(C.lds + 131072); LAS int* cl = blk + 64; LAS int* nbk = blk + 128; const int* cnt = WSP(int, WS_CTL) + 1024 + l * 1024;
    __syncthreads();
    if (C.tid < 32) { const int c = __hip_atomic_load(cnt + 32 * C.tid, __ATOMIC_RELAXED, __HIP_MEMORY_SCOPE_AGENT); cl[C.tid] = c; nbk[C.tid] = (c + 255) >> 8; }
    __syncthreads();
    if (C.tid < 33) { int s_ = 0; for (int e = 0; e < C.tid; ++e) s_ += nbk[e]; blk[C.tid] = s_; }
    __syncthreads();
}
__device__ __forceinline__ void phase_combine(Ctx& C, int l, int nrows, bool last) {
    PHASE_BEGIN(C); PIN_S(l);
    bf16_t* U = WSP(bf16_t, WS_U); const float* modn = WSP(float, WS_MOD) + (size_t)(l + 1) * 5 * 6144;
    float* H = WSP(float, WS_H); const bf16_t* Y = WSP(bf16_t, WS_RA); const float* mod = WSP(float, WS_MOD) + (size_t)l * 5 * 6144;
    const float* g2 = INP(30) + l * D; const float* b2 = INP(31) + l * D; const float* topp = WSP(float, WS_SMALL + 512 * 1024); const int* epos = WSP(int, WS_SMALL + 1 * MiB); const int* topi = WSP(int, WS_SMALL);
    build_blk(C, l); const LAS int* blk = (const LAS int*)(C.lds + 131072);
    const bf16_t* Vb = WSP(bf16_t, WS_V); const float* g1p = INP(22) + l * D; const float* b1p = INP(23) + l * D;
#define CMB_IDX(row_, sl_, te_, pp_) do { sl_ = *(const int4*)(epos + (size_t)(row_) * 4); te_ = *(const int4*)(topi + (size_t)(row_) * 4); pp_ = *(const f32x4*)(topp + (size_t)(row_) * 4); } while (0)
#define CMB_DATA(row_, sl_, te_, yd_, hd_) do { const int s0_ = blk[te_.x] * 256 + sl_.x, s1_ = blk[te_.y] * 256 + sl_.y, s2_ = blk[te_.z] * 256 + sl_.z, s3_ = blk[te_.w] * 256 + sl_.w; \
        _Pragma("unroll") for (int j = 0; j < 4; ++j) { yd_[0][j] = ((const u32x2*)(Y + (size_t)s0_ * D) + C.lane)[64 * j]; yd_[1][j] = ((const u32x2*)(Y + (size_t)s1_ * D) + C.lane)[64 * j]; \
            yd_[2][j] = ((const u32x2*)(Y + (size_t)s2_ * D) + C.lane)[64 * j]; yd_[3][j] = ((const u32x2*)(Y + (size_t)s3_ * D) + C.lane)[64 * j]; { const u32x2 w_ = ((const u32x2*)(Vb + (size_t)(row_) * D) + C.lane)[64 * j]; hd_[j] = (f32x4){bf2f(w_.x & 0xffffu), bf2f(w_.x >> 16), bf2f(w_.y & 0xffffu), bf2f(w_.y >> 16)}; } } } while (0)
    int row = C.gw;
    int4 slA, teA, slB, teB; f32x4 ppA, ppB, ppC;
    slA = make_int4(0, 0, 0, 0); teA = slA; slB = slA; teB = slA; ppA = (f32x4){0.f, 0.f, 0.f, 0.f}; ppB = ppA; ppC = ppA;
    u32x2 yc[4][4], yn[4][4]; f32x4 hc[4], hn[4];
    if (row < nrows) { CMB_IDX(row, slA, teA, ppA); }
    if (row + C.ngw < nrows) { CMB_IDX(row + C.ngw, slB, teB, ppB); }
    if (row < nrows) { CMB_DATA(row, slA, teA, yc, hc); }
    ppC = ppA;
    while (row < nrows) {
        const int nrow = row + C.ngw, nnrow = nrow + C.ngw;
        if (nrow < nrows) { CMB_DATA(nrow, slB, teB, yn, hn); }
        const f32x4 ppN = ppB;
        if (nnrow < nrows) { CMB_IDX(nnrow, slB, teB, ppB); }
        const float pps[4] = {ppC.x, ppC.y, ppC.z, ppC.w};
        f32x4 y[4];
#pragma unroll
        for (int j = 0; j < 4; ++j) y[j] = (f32x4){0.f, 0.f, 0.f, 0.f};
#pragma unroll
        for (int k = 0; k < 4; ++k)
#pragma unroll
            for (int j = 0; j < 4; ++j) { const u32x2 w = yc[k][j]; y[j].x += pps[k] * bf2f(w.x & 0xffffu); y[j].y += pps[k] * bf2f(w.x >> 16); y[j].z += pps[k] * bf2f(w.y & 0xffffu); y[j].w += pps[k] * bf2f(w.y >> 16); }
        const int r = row < NLAT ? (row >> 12) : 4; const f32x4* gg = (const f32x4*)(mod + r * 6144 + 5 * D) + C.lane;
        f32x4* hr = (f32x4*)(H + (size_t)row * D) + C.lane; f32x4 v[4];
#pragma unroll
        for (int j = 0; j < 4; ++j) v[j] = hc[j];
        float mean, rstd; ln_stats(v, mean, rstd, C.lane);
#pragma unroll
        for (int j = 0; j < 4; ++j) { const f32x4 h1 = (v[j] - mean) * rstd * ((const f32x4*)g1p)[C.lane + 64 * j] + ((const f32x4*)b1p)[C.lane + 64 * j]; v[j] = h1 * ALPHA + gg[64 * j] * y[j]; }
        ln_stats(v, mean, rstd, C.lane);
#pragma unroll
        for (int j = 0; j < 4; ++j) v[j] = (v[j] - mean) * rstd * ((const f32x4*)g2)[C.lane + 64 * j] + ((const f32x4*)b2)[C.lane + 64 * j];
        if (last) { if (row < NLAT) { f32x4* orow = (f32x4*)(((float*)C.kp->out) + (size_t)row * D) + C.lane;
#pragma unroll
            for (int j = 0; j < 4; ++j) orow[64 * j] = v[j]; } }
        else {
#pragma unroll
            for (int j = 0; j < 4; ++j) hr[64 * j] = v[j];
            ln_stats(v, mean, rstd, C.lane);
            const f32x4* sh = (const f32x4*)(modn + r * 6144) + C.lane; const f32x4* sc = (const f32x4*)(modn + r * 6144 + D) + C.lane; u32x2* o = (u32x2*)(U + (size_t)row * D) + C.lane;
#pragma unroll
            for (int j = 0; j < 4; ++j) { const f32x4 yy = (v[j] - mean) * rstd * (sc[64 * j] + 1.0f) + sh[64 * j]; u32x2 w; w.x = pk2(yy.x, yy.y); w.y = pk2(yy.z, yy.w); o[64 * j] = w; } }
#pragma unroll
        for (int k = 0; k < 4; ++k)
#pragma unroll
            for (int j = 0; j < 4; ++j) yc[k][j] = yn[k][j];
#pragma unroll
        for (int j = 0; j < 4; ++j) hc[j] = hn[j];
        ppC = ppN; row = nrow;
    }
#undef CMB_IDX
#undef CMB_DATA
}

#ifndef USE_PG8
#define USE_PG8 1
#endif
#define RUN_GEMM(K_, S_, E_) gemm_pg8(C.lds, C.tid, K_, S_, E_)
constexpr int NCVT = 56;
__device__ __forceinline__ void phase_gemm_inproj(Ctx& C, int l) {
    PHASE_BEGIN(C); PIN_S(l);
    const int ngb = C.nb - NCVT;
    if (C.bid >= ngb) { phase0_transposes(C, 1, l, C.bid - ngb, NCVT); return; }
    { SchedInProj S{WSP(bf16_t, WS_U), WSP(bf16_t, WS_WIN) + (size_t)l * PT * D, ngb, C.bid};
      EpiInProj E{WSP(bf16_t, WS_P), INP(7) + (size_t)l * PT, WSP(f32x2, WS_ROPE)};
      RUN_GEMM(D, S, E); }
    { SchedVT S{WSP(bf16_t, WS_WIN) + (size_t)l * PT * D + (size_t)C_V * D, WSP(bf16_t, WS_U), ngb, (C.bid + 96) % ngb};
      EpiVT E{WSP(bf16_t, WS_VT), INP(7) + (size_t)l * PT + C_V};
      RUN_GEMM(D, S, E); }
}
__device__ __forceinline__ void phase_gemm_proj(Ctx& C, int l) {
    PHASE_BEGIN(C); PIN_S(l);
    Sched2D S{WSP(bf16_t, WS_CAT), WSP(bf16_t, WS_WCAT) + (size_t)l * D * 2048, (l == 1 ? NLAT : T) / 256, D / 256, 2048, C.nb, C.bid};
    EpiMerge E{WSP(bf16_t, WS_MERGED), WSP(bf16_t, WS_P)};
    RUN_GEMM(2048, S, E);
}
__device__ __forceinline__ void phase_gemm_wo(Ctx& C, int l) {
    PHASE_BEGIN(C); PIN_S(l);
    Sched2D S{WSP(bf16_t, WS_MERGED), WSP(bf16_t, WS_WO) + (size_t)l * D * D, (l == 1 ? NLAT : T) / 256, D / 256, D, C.nb, C.bid};
    EpiWo E{l == 0 ? INP(0) : WSP(float, WS_H), l == 0 ? INP(2) - (size_t)NLAT * D : WSP(float, WS_H), WSP(bf16_t, WS_V), INP(21) + (size_t)l * D, WSP(float, WS_MOD) + (size_t)l * 5 * 6144};
    RUN_GEMM(D, S, E);
}
__device__ __forceinline__ void phase_gemm_up(Ctx& C, int l) {
    PHASE_BEGIN(C); PIN_S(l);
    build_blk(C, l);
    SchedMoE S{WSP(bf16_t, WS_U), WSP(bf16_t, WS_WGU) + (size_t)l * 32 * 2048 * D, (const LAS int*)(C.lds + 131072), 8, D, C.nb, C.bid, (size_t)2048 * D, WSP(int, WS_ETOK) + (size_t)l * 32 * ECAP, true};
    EpiSwiglu E{WSP(bf16_t, WS_RB) + (size_t)NSLOT * D, INP(27) + (size_t)l * 32 * 2048};
    RUN_GEMM(D, S, E);
}
__device__ __forceinline__ void phase_gemm_dn(Ctx& C, int l) {
    PHASE_BEGIN(C); PIN_S(l);
    build_blk(C, l);
    SchedMoE S{WSP(bf16_t, WS_RB) + (size_t)NSLOT * D, WSP(bf16_t, WS_WDN) + (size_t)l * 32 * D * D, (const LAS int*)(C.lds + 131072), 4, D, C.nb, C.bid, (size_t)D * D, WSP(int, WS_ETOK), false};
    EpiDown E{WSP(bf16_t, WS_RA), INP(29) + (size_t)l * 32 * D};
    RUN_GEMM(D, S, E);
}

__global__ void __launch_bounds__(NTHR, 2) mega(Params p) {
    extern __shared__ __attribute__((aligned(16))) unsigned char lds_raw[];
    cg::grid_group grid = cg::this_grid();
    Ctx C; C.kp = (KP)__builtin_amdgcn_kernarg_segment_ptr(); C.tid = threadIdx.x; C.bid = blockIdx.x; C.nb = gridDim.x; C.lds = (LAS unsigned char*)lds_raw; C.ws = C.kp->ws;
    if (C.tid < 64) ((LAS unsigned*)(C.lds + LDS_CTRL))[C.tid] = 0u;
    __syncthreads();
    (void)xcd_barrier_post((unsigned*)WSP(unsigned, WS_CTL) + 4096, (volatile LAS unsigned*)(C.lds + LDS_CTRL));
#define SYNC() do { PHASE_BEGIN(C); XcdBarrier bb_; bb_.bar = (unsigned*)WSP(unsigned, WS_CTL) + 4096; bb_.x = xb_xcc_id(); bb_.st = (volatile LAS unsigned*)(C.lds + LDS_CTRL); xcd_barrier(bb_); } while (0)
    phase0(C); grid.sync();
    phase_ln0(C, 0); SYNC();
#pragma unroll 1
    for (int l = 0; l < 2; ++l) {
        const bool last = (l == 1); const int nrows = last ? NLAT : T;
        phase_gemm_inproj(C, l); SYNC();
        phase_lru(C, l); phase_attn3(C, l, !last); SYNC();
        phase_gemm_proj(C, l); SYNC();
        phase_gemm_wo(C, l); SYNC();
        phase_ln1(C, l, nrows); SYNC();
        phase_gemm_up(C, l); SYNC();
        phase_gemm_dn(C, l); SYNC();
        phase_combine(C, l, nrows, last); SYNC();
    }
}

extern "C" void kernel_launch(void* const* d_in, const int* in_sizes, int n_in, void* d_out, int out_size, void* d_ws, size_t ws_size, hipStream_t stream) {
    static int grid_blocks = 0;
    if (!grid_blocks) {
        int dev = 0, cus = 0, per_cu = 0;
        (void)hipGetDevice(&dev);
        (void)hipDeviceGetAttribute(&cus, hipDeviceAttributeMultiprocessorCount, dev);
        (void)hipFuncSetAttribute((const void*)mega, hipFuncAttributeMaxDynamicSharedMemorySize, LDS_BYTES);
        (void)hipOccupancyMaxActiveBlocksPerMultiprocessor(&per_cu, (const void*)mega, NTHR, LDS_BYTES);
        if (per_cu < 1 || n_in != 32 || ws_size < WS_END) { fprintf(stderr, "kernel_launch: bad config per_cu %d n_in %d ws %zu\n", per_cu, n_in, ws_size); grid_blocks = -1; return; }
        grid_blocks = cus;
    }
    if (grid_blocks < 0) return;
    (void)hipMemsetAsync(d_ws, 0, 1 * MiB, stream);
    Params p{};
    for (int i = 0; i < 32; ++i) p.in[i] = (const GAS float*)d_in[i];
    p.out = (GAS float*)d_out; p.ws = (GAS unsigned char*)d_ws;
    void* args[] = {&p};
    hipError_t e = hipLaunchCooperativeKernel((void*)mega, dim3(grid_blocks), dim3(NTHR), args, LDS_BYTES, stream);
    if (e != hipSuccess) fprintf(stderr, "cooperative launch failed: %s (grid %d)\n", hipGetErrorString(e), grid_blocks);
}
```

```cpp
#include <hip/hip_runtime.h>
#include <hip/hip_cooperative_groups.h>
#include <cstdio>
#include <cstdint>
namespace cg = cooperative_groups;

typedef unsigned short bf16_t;
typedef short bf16x8 __attribute__((ext_vector_type(8)));
typedef float f32x4 __attribute__((ext_vector_type(4)));
typedef float f32x2 __attribute__((ext_vector_type(2)));
typedef unsigned u32x4 __attribute__((ext_vector_type(4)));
typedef unsigned u32x2 __attribute__((ext_vector_type(2)));
#define LAS __attribute__((address_space(3)))

constexpr int D = 1024, NB = 4, SEQ = 4096, CTX = 256, NLAT = NB * SEQ, NCTX = NB * CTX, T = NLAT + NCTX;
constexpr int PT = 7168, GW = 64;
constexpr int C_Q = 0, C_K = 512, C_V = 1024, C_SB = 1536, C_SCG = 2048, C_SX = 2560, C_LX = 3072, C_LG = 3584, C_GL = 4096;
constexpr int NE = 32, NSLOT = 77824, ECAP = T;
constexpr float LN_EPS = 1e-5f, ALPHA = 1.41421356237f;
constexpr int NWAVES = 8, NTHR = 512;
constexpr int LDS_BYTES = 163840;
constexpr int LDS_CTRL = 163584, LDS_LN1 = 148480;

constexpr size_t MiB = 1u << 20;
constexpr size_t WS_CTL = 0, WS_MODP = 1 * MiB, WS_MOD = 5 * MiB, WS_ROPE = 6 * MiB, WS_WIN = 8 * MiB, WS_WPA = 36 * MiB, WS_WPC = 38 * MiB, WS_WPL = 40 * MiB,
                 WS_WO = 42 * MiB, WS_WGU = 46 * MiB, WS_WDN = 302 * MiB, WS_H = 430 * MiB, WS_V = 498 * MiB, WS_U = 566 * MiB, WS_P = 600 * MiB, WS_ATT = 838 * MiB,
                 WS_SC = 855 * MiB, WS_LRU = 872 * MiB, WS_MERGED = 889 * MiB, WS_SMALL = 923 * MiB, WS_XM = 927 * MiB, WS_RA = 961 * MiB, WS_RB = 1165 * MiB, WS_WPL2 = 1469 * MiB, WS_ETOK = 1473 * MiB, WS_WCAT = 1478 * MiB, WS_END = 1486 * MiB;
constexpr size_t WS_CAT = WS_RB;
constexpr size_t WS_VT = WS_LRU;
constexpr size_t WS_LRU2 = WS_XM;
#define GAS __attribute__((address_space(1)))
struct Params {
    const GAS float* in[32];
    GAS float* out;
    GAS unsigned char* ws;
};

__device__ __forceinline__ float bf2f(unsigned v) { return __uint_as_float(v << 16); }
__device__ __forceinline__ unsigned f2bf(float f) { unsigned u = __float_as_uint(f); return (u + 0x7fffu + ((u >> 16) & 1u)) >> 16; }
typedef __bf16 bf16x2_t __attribute__((ext_vector_type(2)));
__device__ __forceinline__ unsigned pk2(float lo, float hi) { const f32x2 v = {lo, hi}; const bf16x2_t b = __builtin_convertvector(v, bf16x2_t); return __builtin_bit_cast(unsigned, b); }
__device__ __forceinline__ float sigmoidf_(float x) { return __builtin_amdgcn_rcpf(1.0f + __expf(-x)); }
__device__ __forceinline__ float wave_sum(float v, int lane) {
    (void)lane;
    v += __int_as_float(__builtin_amdgcn_update_dpp(0, __float_as_int(v), 0xB1, 0xF, 0xF, true));
    v += __int_as_float(__builtin_amdgcn_update_dpp(0, __float_as_int(v), 0x4E, 0xF, 0xF, true));
    v += __int_as_float(__builtin_amdgcn_update_dpp(0, __float_as_int(v), 0x124, 0xF, 0xF, true));
    v += __int_as_float(__builtin_amdgcn_update_dpp(0, __float_as_int(v), 0x128, 0xF, 0xF, true));
    const float r0 = __int_as_float(__builtin_amdgcn_readlane(__float_as_int(v), 0)), r1 = __int_as_float(__builtin_amdgcn_readlane(__float_as_int(v), 16));
    const float r2 = __int_as_float(__builtin_amdgcn_readlane(__float_as_int(v), 32)), r3 = __int_as_float(__builtin_amdgcn_readlane(__float_as_int(v), 48));
    return (r0 + r1) + (r2 + r3);
}
__device__ __forceinline__ float bperm(int srclane, float v) { return __int_as_float(__builtin_amdgcn_ds_bpermute(srclane << 2, __float_as_int(v))); }
__device__ __forceinline__ void unpack8(const u32x4 w, float* f) {
    f[0] = bf2f(w.x & 0xffffu); f[1] = bf2f(w.x >> 16); f[2] = bf2f(w.y & 0xffffu); f[3] = bf2f(w.y >> 16);
    f[4] = bf2f(w.z & 0xffffu); f[5] = bf2f(w.z >> 16); f[6] = bf2f(w.w & 0xffffu); f[7] = bf2f(w.w >> 16);
}
__device__ __forceinline__ u32x4 pack8(const float* f) { u32x4 w; w.x = pk2(f[0], f[1]); w.y = pk2(f[2], f[3]); w.z = pk2(f[4], f[5]); w.w = pk2(f[6], f[7]); return w; }
__device__ __forceinline__ int perm32(int rho) { const int n = rho >> 4, i = rho & 15; return 8 * (i >> 2) + 4 * n + (i & 3); }
__device__ __forceinline__ float gelu_tanh(float x) { const float u = 0.7978845608028654f * (x + 0.044715f * x * x * x); return 0.5f * x * (1.0f + tanhf(u)); }

struct Unit { int pm, pn, aux, nvalid; const bf16_t* A; const bf16_t* B; const int* idx; };
#define PG8_LAS __attribute__((address_space(3)))
constexpr int BM = 256, BK = 64, HALF = 128, HTB = HALF * BK * 2, STAGE_BYTES = 8 * HTB;
__host__ __device__ __forceinline__ int lds_byte(int r, int c) { const int st = (r >> 4) * 2 + (c >> 5), rr = r & 15, cc = c & 31, ob = rr * 64 + cc * 2; return st * 1024 + (ob ^ (((ob >> 9) & 1) << 5)); }
__host__ __device__ __forceinline__ void stage_rc(int b, int& R, int& C) { const int st = b / 1024, sb = b % 1024, swz = sb ^ (((sb >> 9) & 1) << 5); R = (st >> 1) * 16 + swz / 64; C = (st & 1) * 32 + (swz % 64) / 2; }
template <class Epi, class Sched>
__device__ __forceinline__ void gemm_pg8(PG8_LAS unsigned char* lds, int tid, const int K, const Sched& S, const Epi& E) {
    const int wid = __builtin_amdgcn_readfirstlane(tid >> 6), lane = tid & 63, wr = wid >> 2, wc = wid & 3, fr = lane & 15, fq = lane >> 4;
    const int nt = K / BK;
    unsigned voffB[2]; int RA[2], CA[2];
#pragma unroll
    for (int i = 0; i < 2; ++i) { int R, Cc; stage_rc(tid * 16 + i * 8192, R, Cc); const int Rb = Epi::PERM ? ((R & ~31) + perm32(R & 31)) : R;
        RA[i] = R; CA[i] = Cc; voffB[i] = (unsigned)(Rb * K + Cc) * 2u; }
    const size_t kstep = (size_t)(BK * 2);
    const size_t hstep = (size_t)HALF * K * 2;
    const unsigned ldsw = (unsigned)wid * 1024u;
    const int aoff = lds_byte(wr * 64 + fr, fq * 8), boff = lds_byte(wc * 32 + fr, fq * 8);
#define PG8_SA(b, h) (((b) * 2 + (h)) * HTB)
#define PG8_SB(b, h) ((4 + (b) * 2 + (h)) * HTB)
#define PG8_STAGE(bufoff, gbase, voff) do { _Pragma("unroll") for (int _i = 0; _i < 2; ++_i) \
        __builtin_amdgcn_global_load_lds((const unsigned*)((const char*)(gbase) + (voff)[_i]), (PG8_LAS unsigned*)(lds + (bufoff) + ldsw + _i * 8192), 16, 0, 0); } while (0)
#define PG8_LDA(dst, b, h) do { _Pragma("unroll") for (int m = 0; m < 4; ++m) _Pragma("unroll") for (int k = 0; k < 2; ++k) dst[m][k] = *(const PG8_LAS bf16x8*)(lds + PG8_SA(b, h) + aoff + m * 2048 + k * 1024); } while (0)
#define PG8_LDB(dst, b, h) do { _Pragma("unroll") for (int n = 0; n < 2; ++n) _Pragma("unroll") for (int k = 0; k < 2; ++k) dst[n][k] = *(const PG8_LAS bf16x8*)(lds + PG8_SB(b, h) + boff + n * 2048 + k * 1024); } while (0)
#define PG8_MMA(ai, bj, At, Bt) do { __builtin_amdgcn_s_setprio(1); _Pragma("unroll") for (int m = 0; m < 4; ++m) _Pragma("unroll") for (int n = 0; n < 2; ++n) _Pragma("unroll") for (int k = 0; k < 2; ++k) \
        acc[ai][bj][m][n] = __builtin_amdgcn_mfma_f32_16x16x32_bf16(Bt[n][k], At[m][k], acc[ai][bj][m][n], 0, 0, 0); __builtin_amdgcn_s_setprio(0); } while (0)
#define PG8_WAIT_V(n) asm volatile("s_waitcnt vmcnt(" #n ")" ::: "memory")
#define PG8_WAIT_L(n) asm volatile("s_waitcnt lgkmcnt(" #n ")" ::: "memory")
#define PG8_BAR __builtin_amdgcn_s_barrier()
#define PG8_SCHED __builtin_amdgcn_sched_barrier(0)
#define PG8_VA(dst, u) do { _Pragma("unroll") for (int _h = 0; _h < 2; ++_h) _Pragma("unroll") for (int _i = 0; _i < 2; ++_i) { \
        if constexpr (Epi::GATHER) { const int _p = _h * HALF + RA[_i]; const int _tok = (u).idx ? (_p < (u).nvalid ? (u).idx[_p] : 0) : _p; dst[_h][_i] = (unsigned)(_tok * K + CA[_i]) * 2u; } \
        else dst[_h][_i] = (unsigned)((_h * HALF + RA[_i]) * K + CA[_i]) * 2u; } } while (0)
    Unit cur, nxt; int ui = 0; int pend = -1;
    if (!S.next(0, cur)) return;
    f32x4 acc[2][2][4][2];
#pragma unroll
    for (int a = 0; a < 2; ++a)
#pragma unroll
        for (int b = 0; b < 2; ++b)
#pragma unroll
            for (int m = 0; m < 4; ++m)
#pragma unroll
                for (int n = 0; n < 2; ++n) acc[a][b][m][n] = (f32x4){0.f, 0.f, 0.f, 0.f};
    bf16x8 At[4][2], B0[2][2], B1[2][2];
    unsigned vAc[2][2], vAn[2][2];
    PG8_VA(vAc, cur);
    const char* cA = (const char*)cur.A; const char* cB = (const char*)cur.B;
    PG8_STAGE(PG8_SB(0, 0), cB, voffB); PG8_STAGE(PG8_SB(0, 1), cB + hstep, voffB); PG8_STAGE(PG8_SA(0, 0), cA, vAc[0]); PG8_STAGE(PG8_SA(0, 1), cA, vAc[1]);
    if (wr == 1) PG8_BAR;
    PG8_WAIT_V(2); PG8_BAR;
    PG8_STAGE(PG8_SB(1, 0), cB + kstep, voffB); PG8_STAGE(PG8_SA(1, 0), cA + kstep, vAc[0]); PG8_STAGE(PG8_SB(1, 1), cB + hstep + kstep, voffB);
    PG8_WAIT_V(6); PG8_BAR;
    for (;;) {
        const bool has_next = S.next(ui + 1, nxt);
        const char* nA = has_next ? (const char*)nxt.A : cA; const char* nB = has_next ? (const char*)nxt.B : cB;
        if (Epi::GATHER && has_next) PG8_VA(vAn, nxt);
        else {
#pragma unroll
            for (int h = 0; h < 2; ++h) { vAn[h][0] = vAc[h][0]; vAn[h][1] = vAc[h][1]; } }
        for (int t = 0; t < nt; t += 2) {
            const bool last = (t == nt - 2);
            const char* a1 = cA + (size_t)(t + 1) * kstep;
            const char* a2 = last ? nA : cA + (size_t)(t + 2) * kstep; const char* b2 = last ? nB : cB + (size_t)(t + 2) * kstep;
            const char* a3 = a2 + kstep; const char* b3 = b2 + kstep;
            unsigned v2[2][2];
#pragma unroll
            for (int h = 0; h < 2; ++h) { v2[h][0] = (Epi::GATHER && last) ? vAn[h][0] : vAc[h][0]; v2[h][1] = (Epi::GATHER && last) ? vAn[h][1] : vAc[h][1]; }
            PG8_LDB(B0, 0, 0); PG8_LDB(B1, 0, 1); PG8_SCHED; PG8_LDA(At, 0, 0); PG8_STAGE(PG8_SA(1, 1), a1, vAc[1]);
            PG8_WAIT_V(8); PG8_WAIT_L(0); PG8_BAR; PG8_MMA(0, 0, At, B0); PG8_MMA(0, 1, At, B1); PG8_BAR; PG8_SCHED;
            PG8_LDA(At, 0, 1); PG8_STAGE(PG8_SB(0, 0), b2, voffB); PG8_STAGE(PG8_SB(0, 1), b2 + hstep, voffB); PG8_STAGE(PG8_SA(0, 0), a2, v2[0]);
            PG8_WAIT_V(8); PG8_WAIT_L(0); PG8_BAR; PG8_MMA(1, 0, At, B0); PG8_MMA(1, 1, At, B1); PG8_BAR; PG8_SCHED;
            PG8_LDB(B0, 1, 0); PG8_LDB(B1, 1, 1); PG8_SCHED; PG8_LDA(At, 1, 0); PG8_STAGE(PG8_SA(0, 1), a2, v2[1]);
            PG8_WAIT_V(8); PG8_WAIT_L(0); PG8_BAR; PG8_MMA(0, 0, At, B0); PG8_MMA(0, 1, At, B1); PG8_BAR; PG8_SCHED;
            PG8_LDA(At, 1, 1); PG8_STAGE(PG8_SB(1, 0), b3, voffB); PG8_STAGE(PG8_SB(1, 1), b3 + hstep, voffB); PG8_STAGE(PG8_SA(1, 0), a3, v2[0]);
            PG8_WAIT_V(8); PG8_WAIT_L(0); PG8_BAR; PG8_MMA(1, 0, At, B0); PG8_MMA(1, 1, At, B1); PG8_BAR; PG8_SCHED;
            if constexpr (Epi::KHOOK) { if (t + 2 == Epi::HOOK0 || t + 2 == Epi::HOOK1) E.khook(acc, cur, t + 2, wr, wc, fr, fq); }
        }
        if (wr == 0) PG8_BAR;
        if constexpr (Epi::SIGNAL) { if (pend >= 0) { PG8_WAIT_V(0); PG8_BAR; if (tid == 0) E.signal(pend); pend = -1; } }
        E(acc, cur, wr, wc, fr, fq, lds, wid, lane);
        if constexpr (Epi::SIGNAL) { if (E.produces(cur)) pend = cur.pm; }
        if (!has_next) break;
#pragma unroll
        for (int a = 0; a < 2; ++a)
#pragma unroll
            for (int b = 0; b < 2; ++b)
#pragma unroll
                for (int m = 0; m < 4; ++m)
#pragma unroll
                    for (int n = 0; n < 2; ++n) acc[a][b][m][n] = (f32x4){0.f, 0.f, 0.f, 0.f};
        cur = nxt; cA = nA; cB = nB; ++ui;
#pragma unroll
        for (int h = 0; h < 2; ++h) { vAc[h][0] = vAn[h][0]; vAc[h][1] = vAn[h][1]; }
        if (wr == 1) PG8_BAR;
    }
    PG8_WAIT_V(0);
    PG8_BAR;
    if constexpr (Epi::SIGNAL) { if (pend >= 0 && tid == 0) E.signal(pend); }
#undef PG8_SA
#undef PG8_SB
#undef PG8_STAGE
#undef PG8_LDA
#undef PG8_LDB
#undef PG8_MMA
#undef PG8_WAIT_V
#undef PG8_WAIT_L
#undef PG8_BAR
#undef PG8_SCHED
#undef PG8_VA
}
constexpr int EPI_BUF_A = 3 * HTB, EPI_BUF_B = 132096;
template <class F>
__device__ __forceinline__ void staged_store256(PG8_LAS unsigned char* lds, bf16_t* dst, size_t ldc, int rowtile0, int col0tile, int wr, int wc, int fr, int fq, int wid, int lane, F&& f) {
    const int tr = wr * 16 + fr;
#define SS_WRITE(step_) do { const int ai_ = (step_) >> 2, m_ = (step_) & 3; PG8_LAS unsigned char* wb_ = lds + (((step_) & 1) ? EPI_BUF_B : EPI_BUF_A); \
        _Pragma("unroll") for (int bj = 0; bj < 2; ++bj) { float o[8]; f(ai_, m_, bj, o); const int chunk = 16 * bj + 4 * wc + fq; \
            *(PG8_LAS u32x4*)(wb_ + tr * 512 + ((chunk ^ (tr & 7)) << 4)) = pack8(o); } } while (0)
    SS_WRITE(0);
#pragma unroll
    for (int step = 0; step < 8; ++step) {
        const int ai = step >> 2, m = step & 3; PG8_LAS unsigned char* buf = lds + ((step & 1) ? EPI_BUF_B : EPI_BUF_A);
        asm volatile("s_waitcnt lgkmcnt(0)" ::: "memory"); __builtin_amdgcn_s_barrier(); asm volatile("" ::: "memory");
        if (step < 7) SS_WRITE(step + 1);
#pragma unroll
        for (int k = 0; k < 2; ++k) { const int r2 = 2 * (2 * wid + k) + (lane >> 5), chunk = lane & 31;
            const u32x4 v = *(const PG8_LAS u32x4*)(buf + r2 * 512 + ((chunk ^ (r2 & 7)) << 4));
            *(u32x4*)(dst + (size_t)(rowtile0 + ai * 128 + (r2 >> 4) * 64 + m * 16 + (r2 & 15)) * ldc + col0tile + chunk * 8) = v; }
    }
#undef SS_WRITE
}
__device__ __forceinline__ int xcd_chunk(int L, int nwg) { const int q = nwg / 8, r = nwg % 8, x = L % 8, off = L / 8; return (x < r ? x * (q + 1) : r * (q + 1) + (x - r) * q) + off; }
__device__ __forceinline__ void grouped_pm_pn(int wgid, int nM, int nN, int& pm, int& pn) {
    const int nig = 8 * nN, gid = wgid / nig, fm = gid * 8, gsz = (nM - fm) < 8 ? (nM - fm) : 8; pm = fm + ((wgid % nig) % gsz); pn = (wgid % nig) / gsz; }
struct Sched2D {
    const bf16_t* A; const bf16_t* B; int nM, nN, K, G, c;
    __device__ __forceinline__ bool next(int i, Unit& u) const {
        const int L = i * G + c, nwg = nM * nN; if (L >= nwg) return false;
        grouped_pm_pn(xcd_chunk(L, nwg), nM, nN, u.pm, u.pn); u.aux = 0; u.nvalid = 0; u.idx = nullptr; u.A = A + (size_t)u.pm * 256 * K; u.B = B + (size_t)u.pn * 256 * K; return true;
    }
};
struct SchedInProj {
    const bf16_t* A; const bf16_t* B; int G, c, lastl;
    __device__ __forceinline__ bool next(int i, Unit& u) const {
        const int nfull = lastl ? (NLAT / 256) : (T / 256), nwg = nfull * 26 + (lastl ? 4 * 6 : 0);
        const int L0 = i * G + c; if (L0 >= nwg) return false;
        const int L = xcd_chunk(L0, nwg);
        if (L < nfull * 26) { int q; grouped_pm_pn(L, nfull, 26, u.pm, q); u.pn = q < 4 ? q : q + 2; }
        else { const int Lc = L - nfull * 26, q6 = Lc % 6; u.pm = nfull + Lc / 6; u.pn = q6 < 2 ? 2 + q6 : 10 + q6; }
        u.aux = 0; u.nvalid = 0; u.idx = nullptr;
        u.A = A + (size_t)u.pm * 256 * D; u.B = B + (size_t)u.pn * 256 * D; return true;
    }
};
struct SchedVT {
    const bf16_t* A; const bf16_t* B; int G, c;
    __device__ __forceinline__ bool next(int i, Unit& u) const {
        const int L0 = i * G + c, nwg = 2 * (T / 256); if (L0 >= nwg) return false;
        const int L = xcd_chunk(L0, nwg); u.pm = L & 1; u.pn = L >> 1; u.aux = 0; u.nvalid = 0; u.idx = nullptr; u.A = A + (size_t)u.pm * 256 * D; u.B = B + (size_t)u.pn * 256 * D; return true;
    }
};
struct EpiVT {
    static constexpr bool PERM = true, GATHER = false, KHOOK = false, SIGNAL = false; static constexpr int HOOK0 = -1, HOOK1 = -1;
    bf16_t* VT; const float* bv;
    __device__ __forceinline__ void operator()(const f32x4 (&acc)[2][2][4][2], const Unit& u, int wr, int wc, int fr, int fq, PG8_LAS unsigned char* lds, int wid, int lane) const {
        const int row0 = u.pm * 256 + wr * 64 + fr;
        staged_store256(lds, VT, T, u.pm * 256, u.pn * 256, wr, wc, fr, fq, wid, lane, [&](int ai, int m, int bj, float* o) {
            const float bb = bv[row0 + ai * 128 + m * 16];
#pragma unroll
            for (int n = 0; n < 2; ++n) { const f32x4 v = acc[ai][bj][m][n]; o[4 * n] = v[0] + bb; o[4 * n + 1] = v[1] + bb; o[4 * n + 2] = v[2] + bb; o[4 * n + 3] = v[3] + bb; } });
    }
};

struct EpiMerge {
    static constexpr bool PERM = true, GATHER = false, KHOOK = true, SIGNAL = false; static constexpr int HOOK0 = 8, HOOK1 = 16;
    bf16_t* M; const bf16_t* P;
    __device__ __forceinline__ void khook(f32x4 (&acc)[2][2][4][2], const Unit& u, int kt, int wr, int wc, int fr, int fq) const {
        const int row0 = u.pm * 256 + wr * 64 + fr, col0 = u.pn * 256 + wc * 32 + 8 * fq; const int ja = kt == HOOK0 ? 0 : 1;
        const GAS bf16_t* g = (const GAS bf16_t*)(P + (size_t)row0 * PT + C_GL + ja * D + col0);
        u32x4 qa[2][4], qb[2][4];
#define MG_LOAD(slot_) do { _Pragma("unroll") for (int mm = 0; mm < 2; ++mm) _Pragma("unroll") for (int bj = 0; bj < 2; ++bj) { \
            qa[slot_][mm * 2 + bj] = *(const GAS u32x4*)(g + (size_t)mm * 16 * PT + bj * 128); qb[slot_][mm * 2 + bj] = *(const GAS u32x4*)(g + (size_t)mm * 16 * PT + D + bj * 128); } } while (0)
#define MG_USE(slot_, ai_, m0_) do { _Pragma("unroll") for (int mm = 0; mm < 2; ++mm) _Pragma("unroll") for (int bj = 0; bj < 2; ++bj) { float sa[8], sb[8]; unpack8(qa[slot_][mm * 2 + bj], sa); unpack8(qb[slot_][mm * 2 + bj], sb); \
            _Pragma("unroll") for (int n = 0; n < 2; ++n) _Pragma("unroll") for (int j = 0; j < 4; ++j) acc[ai_][bj][(m0_) + mm][n][j] *= sb[4 * n + j] * __builtin_amdgcn_rcpf(sa[4 * n + j]); } } while (0)
        MG_LOAD(0); g += (size_t)32 * PT; asm volatile("" : "+v"(g) :: "memory");
        MG_LOAD(1); g += (size_t)96 * PT; asm volatile("" : "+v"(g) :: "memory");
        MG_USE(0, 0, 0);
        MG_LOAD(0); g += (size_t)32 * PT; asm volatile("" : "+v"(g) :: "memory");
        MG_USE(1, 0, 2);
        MG_LOAD(1); asm volatile("" : "+v"(g) :: "memory");
        MG_USE(0, 1, 0);
        MG_USE(1, 1, 2);
#undef MG_LOAD
#undef MG_USE
    }
    __device__ __forceinline__ void operator()(const f32x4 (&acc)[2][2][4][2], const Unit& u, int wr, int wc, int fr, int fq, PG8_LAS unsigned char* lds, int wid, int lane) const {
        const int row0 = u.pm * 256 + wr * 64 + fr, col0 = u.pn * 256 + wc * 32 + 8 * fq;
        const bf16_t* g = P + (size_t)row0 * PT + C_GL + 2 * D + col0;
        u32x4 gq[16];
#pragma unroll
        for (int s_ = 0; s_ < 16; ++s_) gq[s_] = *(const u32x4*)(g + (size_t)((s_ >> 3) * 128 + ((s_ >> 1) & 3) * 16) * PT + (s_ & 1) * 128);
        staged_store256(lds, M, D, u.pm * 256, u.pn * 256, wr, wc, fr, fq, wid, lane, [&](int ai, int m, int bj, float* o) {
            float s2[8]; unpack8(gq[(ai * 4 + m) * 2 + bj], s2);
#pragma unroll
            for (int n = 0; n < 2; ++n)
#pragma unroll
                for (int j = 0; j < 4; ++j) o[4 * n + j] = acc[ai][bj][m][n][j] * __builtin_amdgcn_rcpf(s2[4 * n + j]); });
    }
};
struct EpiInProj {
    static constexpr bool PERM = true, GATHER = false, KHOOK = false, SIGNAL = false; static constexpr int HOOK0 = -1, HOOK1 = -1;
    bf16_t* P; const float* bias; const f32x2* rope;
    __device__ __forceinline__ void operator()(const f32x4 (&acc)[2][2][4][2], const Unit& u, int wr, int wc, int fr, int fq, PG8_LAS unsigned char* lds, int wid, int lane) const {
        const int row0 = u.pm * 256 + wr * 64 + fr, col0 = u.pn * 256 + wc * 32 + 8 * fq;
        const bool ropet = (u.pn < 4), gate = (u.pn >= 16);
        const bool upper = fq >= 2; const int fi0 = 8 * (fq & 1);
#pragma unroll
        for (int ai = 0; ai < 2; ++ai)
#pragma unroll
            for (int m = 0; m < 4; ++m) {
                const int row = row0 + ai * 128 + m * 16;
                const int s = row & (SEQ - 1); const int pos = (wc & 1) ? (s & 63) : (s >> 6);
                const bool dorope = ropet && (row < NLAT);
#pragma unroll
                for (int bj = 0; bj < 2; ++bj) {
                    float o[8];
#pragma unroll
                    for (int n = 0; n < 2; ++n) { const f32x4 v = acc[ai][bj][m][n] + *(const f32x4*)(bias + col0 + bj * 128 + 4 * n); o[4 * n] = v[0]; o[4 * n + 1] = v[1]; o[4 * n + 2] = v[2]; o[4 * n + 3] = v[3]; }
                    if (gate) {
#pragma unroll
                        for (int j = 0; j < 8; ++j) o[j] = fminf(1.0f + __expf(-o[j]), 1e20f); }
                    if (ropet) {
#pragma unroll
                        for (int j = 0; j < 8; ++j) { const auto rr = __builtin_amdgcn_permlane32_swap(__float_as_uint(o[j]), __float_as_uint(o[j]), false, false);
                            const float partner = __uint_as_float(upper ? rr[0] : rr[1]); const f32x2 cs = rope[pos * 16 + fi0 + j];
                            const float rot = upper ? (partner * cs.y + o[j] * cs.x) : (o[j] * cs.x - partner * cs.y);
                            o[j] = dorope ? rot : o[j]; } }
                    *(u32x4*)(P + (size_t)row * PT + col0 + bj * 128) = pack8(o);
                }
            }
    }
};
struct EpiWo {
    static constexpr bool PERM = true, GATHER = false, KHOOK = false, SIGNAL = false; static constexpr int HOOK0 = -1, HOOK1 = -1;
    const float* h; const float* hc; bf16_t* V; const float* bo; const float* mod;
    __device__ __forceinline__ void operator()(const f32x4 (&acc)[2][2][4][2], const Unit& u, int wr, int wc, int fr, int fq, PG8_LAS unsigned char* lds, int wid, int lane) const {
        const int row0 = u.pm * 256 + wr * 64 + fr, col0 = u.pn * 256 + wc * 32 + 8 * fq;
        const float* hb = u.pm < NLAT / 256 ? h : hc; const int r = u.pm < NLAT / 256 ? (u.pm >> 4) : 4; const float* g1 = mod + r * 6144 + 2 * D;
        staged_store256(lds, V, D, u.pm * 256, u.pn * 256, wr, wc, fr, fq, wid, lane, [&](int ai, int m, int bj, float* o) {
            const int col = col0 + bj * 128; const size_t off = (size_t)(row0 + ai * 128 + m * 16) * D + col;
#pragma unroll
            for (int n = 0; n < 2; ++n) { const f32x4 y = acc[ai][bj][m][n] + *(const f32x4*)(bo + col + 4 * n);
                const f32x4 v = *(const f32x4*)(hb + off + 4 * n) * ALPHA + *(const f32x4*)(g1 + col + 4 * n) * y; o[4 * n] = v[0]; o[4 * n + 1] = v[1]; o[4 * n + 2] = v[2]; o[4 * n + 3] = v[3]; } });
    }
};
struct SchedMoEF {
    const bf16_t* U; const bf16_t* HID; const bf16_t* WGU; const bf16_t* WDN; const LAS int* blk; const int* etok; int* done; int rk, nxw, R0, nrb;
    __device__ __forceinline__ bool next(int i, Unit& u) const {
        const int j = rk + i * nxw; if (j >= 12 * nrb) return false;
        const int kind = j >= 8 * nrb ? 1 : 0; const int jj = kind ? j - 8 * nrb : j;
        const int rb = R0 + (kind ? (jj >> 2) : (jj >> 3)); u.pn = kind ? (jj & 3) : (jj & 7); u.pm = rb;
        int e = 0;
#pragma unroll 1
        for (int q = 1; q < 32; ++q) if (rb >= blk[q]) e = q;
        const int rbl = rb - blk[e];
        u.aux = e + 32 * kind; u.nvalid = blk[64 + e] - rbl * 256; u.idx = kind ? nullptr : etok + (size_t)e * ECAP + rbl * 256;
        u.A = kind ? HID + (size_t)rb * 256 * D : U; u.B = kind ? WDN + (size_t)e * D * D + (size_t)u.pn * 256 * D : WGU + (size_t)e * 2048 * D + (size_t)u.pn * 256 * D;
        if (kind) {
            unsigned sp = 0; while (__hip_atomic_load(done + rb, __ATOMIC_RELAXED, __HIP_MEMORY_SCOPE_AGENT) < 8) { __builtin_amdgcn_s_sleep(2); if (++sp > (1u << 22)) break; }
            asm volatile("" ::: "memory"); }
        return true;
    }
};
struct EpiMoE {
    static constexpr bool PERM = true, GATHER = true, KHOOK = false, SIGNAL = true; static constexpr int HOOK0 = -1, HOOK1 = -1;
    bf16_t* H; const float* bgu; bf16_t* Y; const float* bdn; int* done;
    __device__ __forceinline__ bool produces(const Unit& u) const { return u.aux < 32; }
    __device__ __forceinline__ void signal(int rb) const { __hip_atomic_fetch_add(done + rb, 1, __ATOMIC_RELAXED, __HIP_MEMORY_SCOPE_AGENT); }
    __device__ __forceinline__ void operator()(const f32x4 (&acc)[2][2][4][2], const Unit& u, int wr, int wc, int fr, int fq, PG8_LAS unsigned char* lds, int wid, int lane) const {
        if (u.aux < 32) {
            const int row0 = u.pm * 256 + wr * 64 + fr, hc0 = u.pn * 128 + wc * 32 + 8 * fq;
            const float* bg = bgu + u.aux * 2048 + hc0; const float* bu = bg + 1024;
            f32x4 bgv[2], buv[2];
#pragma unroll
            for (int n = 0; n < 2; ++n) { bgv[n] = *(const f32x4*)(bg + 4 * n); buv[n] = *(const f32x4*)(bu + 4 * n); }
#pragma unroll
            for (int ai = 0; ai < 2; ++ai)
#pragma unroll
                for (int m = 0; m < 4; ++m) {
                    float o[8];
#pragma unroll
                    for (int n = 0; n < 2; ++n) { const f32x4 g = acc[ai][0][m][n] + bgv[n], up = acc[ai][1][m][n] + buv[n];
#pragma unroll
                        for (int j = 0; j < 4; ++j) { const float gg = fminf(g[j], 7.0f), uu = fminf(fmaxf(up[j], -7.0f), 7.0f); o[4 * n + j] = (uu + 1.0f) * gg * sigmoidf_(1.702f * gg); } }
                    *(u32x4*)(H + (size_t)(row0 + ai * 128 + m * 16) * D + hc0) = pack8(o);
                }
        } else {
            const float* bb = bdn + (u.aux - 32) * 1024 + u.pn * 256 + wc * 32 + 8 * fq;
            f32x4 bv[2][2];
#pragma unroll
            for (int bj = 0; bj < 2; ++bj)
#pragma unroll
                for (int n = 0; n < 2; ++n) bv[bj][n] = *(const f32x4*)(bb + bj * 128 + 4 * n);
            int ln = lane; asm volatile("" : "+v"(ln));
            staged_store256(lds, Y, D, u.pm * 256, u.pn * 256, wr, wc, fr, fq, wid, ln, [&](int ai, int m, int bj, float* o) {
#pragma unroll
                for (int n = 0; n < 2; ++n) { const f32x4 v = acc[ai][bj][m][n] + bv[bj][n]; o[4 * n] = v[0]; o[4 * n + 1] = v[1]; o[4 * n + 2] = v[2]; o[4 * n + 3] = v[3]; } });
        }
    }
};

typedef GAS unsigned gu32;
#define XB_TMO      128
#define XB_XCNT(j)  (256  + 64 * (j))
#define XB_XSUB(j)  (1280 + 64 * (j))
#define XB_XGEN(j)  (2304 + 64 * (j))
#define XB_TOP      3328
#define XB_TOPGEN   3392
#define XCD_BAR_WORDS 3456
#define XB_SPIN_CAP (1u << 18)

__device__ __forceinline__ unsigned xb_ld(unsigned* p)              { return __hip_atomic_load(p, __ATOMIC_RELAXED, __HIP_MEMORY_SCOPE_AGENT); }
__device__ __forceinline__ unsigned xb_add(unsigned* p, unsigned v) { return __hip_atomic_fetch_add(p, v, __ATOMIC_RELAXED, __HIP_MEMORY_SCOPE_AGENT); }
__device__ __forceinline__ unsigned xb_xcc_id() { return (unsigned)__builtin_amdgcn_s_getreg((3 << 11) | 20) & 0xFu; }
#define XB_SPIN(cond, bar) do { unsigned _sp = 0; while (cond) { __builtin_amdgcn_s_sleep(1); \
    if ((++_sp & 255u) == 0u) { if (xb_ld(&(bar)[XB_TMO])) break; if (_sp > XB_SPIN_CAP) { atomicAdd(&(bar)[XB_TMO], 1u); break; } } } } while (0)

struct XcdBarrier {
    unsigned* bar; unsigned x;
    volatile LAS unsigned* st;
};

__device__ __forceinline__ XcdBarrier xcd_barrier_post(unsigned* bar, volatile LAS unsigned* st) {
    XcdBarrier b; b.bar = bar; b.x = xb_xcc_id(); b.st = st;
    if (threadIdx.x == 0) (void)xb_add(&bar[XB_XCNT(b.x)], 1u);
    return b;
}
__device__ __forceinline__ void xcd_barrier_complete(unsigned* bar, unsigned x, unsigned& nloc, unsigned& nx) {
    const unsigned G = gridDim.x * gridDim.y * gridDim.z;
    unsigned sum, cnt, mine, sp = 0u;
    for (;;) {
        sum = 0u; cnt = 0u; mine = 0u;
#pragma unroll
        for (unsigned j = 0; j < 16; ++j) { const unsigned c = xb_ld(&bar[XB_XCNT(j)]); sum += c; cnt += (c > 0u) ? 1u : 0u; mine = (j == x) ? c : mine; }
        if (sum == G) break;
        __builtin_amdgcn_s_sleep(1);
        if ((++sp & 255u) == 0u) { if (xb_ld(&bar[XB_TMO])) break; if (sp > XB_SPIN_CAP) { atomicAdd(&bar[XB_TMO], 1u); break; } }
    }
    nloc = mine > 0u ? mine : 1u; nx = cnt > 0u ? cnt : 1u;
}

__device__ __forceinline__ void xcd_barrier(const XcdBarrier& b) {
    asm volatile("s_waitcnt vmcnt(0)" ::: "memory");
    __syncthreads();
    if (threadIdx.x == 0) {
        unsigned* bar = b.bar;
        __builtin_amdgcn_s_waitcnt(0);
        unsigned nloc = b.st[0], nx = b.st[1];
        if (nloc == 0u) { xcd_barrier_complete(bar, b.x, nloc, nx); b.st[0] = nloc; b.st[1] = nx; }
        const unsigned old = xb_add(&bar[XB_XSUB(b.x)], 1u);
        const unsigned gen = old / nloc;
        if (old + 1u == (gen + 1u) * nloc) {
            __builtin_amdgcn_fence(__ATOMIC_RELEASE, "agent");
            asm volatile("s_waitcnt vmcnt(0)" ::: "memory");
            const unsigned og = xb_add(&bar[XB_TOP], 1u);
            const unsigned tg = og / nx;
            if (og + 1u == (tg + 1u) * nx) xb_add(&bar[XB_TOPGEN], 1u);
            else XB_SPIN(xb_ld(&bar[XB_TOPGEN]) == tg, bar);
            __builtin_amdgcn_fence(__ATOMIC_ACQUIRE, "agent");
            xb_add(&bar[XB_XGEN(b.x)], 1u);
            asm volatile("s_waitcnt vmcnt(0)" ::: "memory");
        } else {
            XB_SPIN(xb_ld(&bar[XB_XGEN(b.x)]) == gen, bar);
            __builtin_amdgcn_fence(__ATOMIC_ACQUIRE, "agent");
            asm volatile("s_waitcnt vmcnt(0)" ::: "memory");
        }
    }
    __syncthreads();
}

typedef const __attribute__((address_space(4))) Params* KP;
struct Ctx {
    KP kp; int tid, lane, wave, bid, nb, gw, ngw; size_t gtid, gthr; LAS unsigned char* lds;
    GAS unsigned char* ws;
};
#define PHASE_BEGIN(C) do { asm volatile("" : "+s"(C.kp)); asm volatile("" : "+s"(C.ws)); asm volatile("" : "+v"(C.tid)); asm volatile("" : "+s"(C.bid)); asm volatile("" : "+s"(C.lds)); \
    C.lane = C.tid & 63; C.wave = __builtin_amdgcn_readfirstlane(C.tid >> 6); C.gw = C.bid * NWAVES + C.wave; C.ngw = C.nb * NWAVES; \
    C.gtid = (size_t)C.bid * NTHR + C.tid; C.gthr = (size_t)C.nb * NTHR; } while (0)
#define PIN_S(x) asm volatile("" : "+s"(x))
#define WSP(T_, off) ((T_*)(GAS T_*)(C.ws + (off)))
#define INP(i) ((const float*)C.kp->in[i])

struct TrFam { const float* W; bf16_t* WT; int nmat, K, N, ldk, koff, gu, first; };
__device__ __forceinline__ void tr_decode(const TrFam& F, int it, const float*& src, bf16_t*& dst, int& d0, int& d1, int& Nn, int& ldk) {
    const int nnb = F.N / 256, per = (F.K / 128) * nnb; const int r0 = it - F.first, mi = r0 / per, r = r0 % per, kb = r / nnb, n0 = (r % nnb) * 256;
    src = F.W + (size_t)mi * F.K * F.N + (size_t)(kb * 128) * F.N + n0; dst = F.WT + (size_t)mi * F.ldk * F.N + F.koff + kb * 128; Nn = F.N; ldk = F.ldk;
    if (F.gu) { const int bj = n0 >> 10, j = n0 & 1023; d0 = 256 * (j >> 7) + 128 * bj; d1 = 256 * ((j + 128) >> 7) + 128 * bj; } else { d0 = n0; d1 = n0 + 128; }
}
__device__ __forceinline__ void phase0_transposes(Ctx& C, int which, int lsel, int bi, int nbk, int it0 = 0, int it1 = 0x7fffffff) {
    TrFam F[6]; int tot = 0;
    if (which == 0) {
      const float* srcs[6] = {INP(6), INP(9), INP(10), INP(11), INP(11), INP(20)};
      bf16_t* dsts[6] = {WSP(bf16_t, WS_WIN), WSP(bf16_t, WS_WCAT), WSP(bf16_t, WS_WCAT), WSP(bf16_t, WS_WCAT), WSP(bf16_t, WS_WCAT), WSP(bf16_t, WS_WO)};
      const int Ks[6] = {D, 512, 512, 512, 512, D}, Ns[6] = {PT, D, D, D, D, D}, ld[6] = {D, 2048, 2048, 2048, 2048, D}, ko[6] = {0, 0, 512, 1024, 1536, 0};
#pragma unroll
      for (int f = 0; f < 6; ++f) { F[f].W = srcs[f]; F[f].WT = dsts[f]; F[f].nmat = 2; F[f].K = Ks[f]; F[f].N = Ns[f]; F[f].ldk = ld[f]; F[f].koff = ko[f]; F[f].gu = 0; F[f].first = tot; tot += 2 * (Ks[f] / 128) * (Ns[f] / 256); }
    } else {
      F[0].W = INP(26) + (size_t)lsel * 32 * D * 2048; F[0].WT = WSP(bf16_t, WS_WGU) + (size_t)lsel * 32 * 2048 * D; F[0].nmat = 32; F[0].K = D; F[0].N = 2048; F[0].ldk = D; F[0].koff = 0; F[0].gu = 1; F[0].first = 0; tot = 32 * 8 * 8;
      F[1].W = INP(28) + (size_t)lsel * 32 * D * D; F[1].WT = WSP(bf16_t, WS_WDN) + (size_t)lsel * 32 * D * D; F[1].nmat = 32; F[1].K = D; F[1].N = D; F[1].ldk = D; F[1].koff = 0; F[1].gu = 0; F[1].first = tot; tot += 32 * 8 * 4;
#pragma unroll
      for (int f = 2; f < 6; ++f) { F[f] = F[1]; F[f].first = 0x7fffffff; }
    }
    const int lane = C.lane, w = C.wave;
    f32x4 va[16], vb[16];
    const float* src; bf16_t* dst; int d0, d1, Nn, ldk;
    bf16_t* dstA = nullptr; bf16_t* dstB = nullptr; int d0A = 0, d1A = 0, ldA = 0, d0B = 0, d1B = 0, ldB = 0;
#define TR_FIND(it_) do { int f_ = 0; _Pragma("unroll") for (int q_ = 1; q_ < 6; ++q_) if ((it_) >= F[q_].first) f_ = q_; \
        TrFam G_ = F[0]; _Pragma("unroll") for (int q_ = 1; q_ < 6; ++q_) if (f_ == q_) G_ = F[q_]; tr_decode(G_, (it_), src, dst, d0, d1, Nn, ldk); } while (0)
#define TR_LOAD(v_) do { const float* p_ = src + (size_t)(16 * w) * Nn + 4 * lane; _Pragma("unroll") for (int i = 0; i < 16; ++i) v_[i] = __builtin_nontemporal_load((const f32x4*)(p_ + (size_t)i * Nn)); } while (0)
#define TR_EMIT(v_, dst_, d0_, d1_, ld_, par_) do { LAS unsigned* Tl = (LAS unsigned*)(C.lds + (par_) * 67584); \
        _Pragma("unroll") for (int j = 0; j < 8; ++j) _Pragma("unroll") for (int c = 0; c < 4; ++c) Tl[(4 * lane + c) * 65 + ((8 * w + j) ^ ((lane >> 3) & 3))] = pk2(v_[2 * j][c], v_[2 * j + 1][c]); } while (0)
#define TR_STORE(dst_, d0_, d1_, ld_, par_) do { const LAS unsigned* Tl = (const LAS unsigned*)(C.lds + (par_) * 67584); const int kc = lane & 15, nr = lane >> 4; \
        _Pragma("unroll") for (int q = 0; q < 8; ++q) { const int n = 32 * w + 4 * q + nr; const LAS unsigned* tp = Tl + n * 65 + 4 * kc; \
            const int sw_ = w & 3; u32x4 o; o.x = tp[0 ^ sw_]; o.y = tp[1 ^ sw_]; o.z = tp[2 ^ sw_]; o.w = tp[3 ^ sw_]; const int drow = (n < 128 ? (d0_) : (d1_) - 128) + n; \
            *(u32x4*)((dst_) + (size_t)drow * (ld_) + 8 * kc) = o; } } while (0)
#pragma unroll
    for (int i = 0; i < 16; ++i) { va[i] = (f32x4){0.f, 0.f, 0.f, 0.f}; vb[i] = va[i]; }
    if (it1 < tot) tot = it1;
    int it = it0 + bi;
    if (it < tot) { TR_FIND(it); TR_LOAD(va); dstA = dst; d0A = d0; d1A = d1; ldA = ldk; }
    if (it + nbk < tot) { TR_FIND(it + nbk); TR_LOAD(vb); dstB = dst; d0B = d0; d1B = d1; ldB = ldk; }
    while (it < tot) {
        TR_EMIT(va, dstA, d0A, d1A, ldA, 0);
        bf16_t* cd = dstA; const int c0 = d0A, c1 = d1A, cl = ldA;
        if (it + 2 * nbk < tot) { TR_FIND(it + 2 * nbk); TR_LOAD(va); dstA = dst; d0A = d0; d1A = d1; ldA = ldk; }
        __syncthreads();
        TR_STORE(cd, c0, c1, cl, 0);
        it += nbk; if (it >= tot) break;
        TR_EMIT(vb, dstB, d0B, d1B, ldB, 1);
        cd = dstB; const int e0 = d0B, e1 = d1B, el = ldB;
        if (it + 2 * nbk < tot) { TR_FIND(it + 2 * nbk); TR_LOAD(vb); dstB = dst; d0B = d0; d1B = d1; ldB = ldk; }
        __syncthreads();
        TR_STORE(cd, e0, e1, el, 1);
        it += nbk;
    }
    __syncthreads();
#undef TR_FIND
#undef TR_EMIT
#undef TR_STORE
#undef TR_LOAD
}
__device__ __forceinline__ void phase0(Ctx& C) {
    PHASE_BEGIN(C);

    phase0_transposes(C, 0, 0, C.bid, C.nb);
    { float* mod = WSP(float, WS_MOD); const float* c = INP(1); const float* cc = INP(3); const float* wm = INP(4); const float* bm = INP(5);
      LAS float* red = (LAS float*)(C.lds + 8 * 16384);
      red = (LAS float*)(C.lds + 131072);
      LAS float* sl = (LAS float*)(C.lds + 131072 + 10240);
      __syncthreads();
      for (int i = C.tid; i < 5 * D; i += NTHR) { const int r = i >> 10, k = i & (D - 1); const float x = r < 4 ? c[r * D + k] : cc[k]; sl[k * 5 + r] = x * sigmoidf_(x); }
      __syncthreads();
      for (int item = C.bid; item < 2 * 192; item += C.nb) {
          const int l = item / 192, j = (item % 192) * 32 + (C.tid & 31), kc = C.tid >> 5;
          float a0 = 0.f, a1 = 0.f, a2 = 0.f, a3 = 0.f, a4 = 0.f;
#pragma unroll 16
          for (int k = kc * 64; k < kc * 64 + 64; ++k) {
              const float w = wm[((size_t)l * D + k) * 6144 + j];
              a0 += sl[k * 5] * w; a1 += sl[k * 5 + 1] * w; a2 += sl[k * 5 + 2] * w; a3 += sl[k * 5 + 3] * w; a4 += sl[k * 5 + 4] * w;
          }
          __syncthreads();
          red[(0 * 16 + kc) * 32 + (C.tid & 31)] = a0; red[(1 * 16 + kc) * 32 + (C.tid & 31)] = a1; red[(2 * 16 + kc) * 32 + (C.tid & 31)] = a2;
          red[(3 * 16 + kc) * 32 + (C.tid & 31)] = a3; red[(4 * 16 + kc) * 32 + (C.tid & 31)] = a4;
          __syncthreads();
          if (C.tid < 160) { const int r = C.tid >> 5, jj = C.tid & 31; float sacc = bm[l * 6144 + (item % 192) * 32 + jj];
              for (int q = 0; q < 16; ++q) sacc += red[(r * 16 + q) * 32 + jj];
              mod[((size_t)l * 5 + r) * 6144 + (item % 192) * 32 + jj] = sacc; }
      } }
    { f32x2* rope = WSP(f32x2, WS_ROPE);
      for (size_t it = C.gtid; it < 64 * 16; it += C.gthr) { const int pos = (int)(it >> 4), i = (int)(it & 15); const float inv = powf(10000.0f, -(float)i / 16.0f); const float ang = (float)pos * inv; rope[it] = (f32x2){cosf(ang), sinf(ang)}; } }
}
__device__ __forceinline__ void ln_stats(f32x4 (&v)[4], float& mean, float& rstd, int lane) {
    float s = 0.f;
#pragma unroll
    for (int j = 0; j < 4; ++j) s += (v[j].x + v[j].y) + (v[j].z + v[j].w);
    mean = wave_sum(s, lane) * (1.f / D); float s2 = 0.f;
#pragma unroll
    for (int j = 0; j < 4; ++j) { const f32x4 d = v[j] - mean; s2 += (d.x * d.x + d.y * d.y) + (d.z * d.z + d.w * d.w); }
    rstd = __builtin_amdgcn_rsqf(wave_sum(s2, lane) * (1.f / D) + LN_EPS);
}
__device__ __forceinline__ void lds_vec_copy(Ctx& C, int off, const float* src, float add) {
    if (C.tid < 256) { f32x4 v = ((const f32x4*)src)[C.tid]; v = v + add; ((LAS f32x4*)(C.lds + off))[C.tid] = v; }
}
__device__ __forceinline__ f32x4 bf4(const u32x2 w_) { return (f32x4){bf2f(w_.x & 0xffffu), bf2f(w_.x >> 16), bf2f(w_.y & 0xffffu), bf2f(w_.y >> 16)}; }
__device__ __forceinline__ void phase_ln0(Ctx& C, int l) {
    PHASE_BEGIN(C); PIN_S(l);
    const float* hx = INP(0); const float* hcx = INP(2) - (size_t)NLAT * D; bf16_t* U = WSP(bf16_t, WS_U); const float* mod = WSP(float, WS_MOD) + (size_t)l * 5 * 6144;
    __syncthreads();
    for (int r = 0; r < 5; ++r) { lds_vec_copy(C, r * 4096, mod + r * 6144, 0.f); lds_vec_copy(C, 20480 + r * 4096, mod + r * 6144 + D, 1.0f); }
    __syncthreads();
    f32x4 vn[4];
#pragma unroll
    for (int j = 0; j < 4; ++j) vn[j] = (f32x4){0.f, 0.f, 0.f, 0.f};
    if (C.gw < T) { const f32x4* xr = (const f32x4*)((C.gw < NLAT ? hx : hcx) + (size_t)C.gw * D) + C.lane;
#pragma unroll
        for (int j = 0; j < 4; ++j) vn[j] = xr[64 * j]; }
    for (int row = C.gw; row < T; row += C.ngw) {
        f32x4 v[4];
#pragma unroll
        for (int j = 0; j < 4; ++j) v[j] = vn[j];
        const int nrow = row + C.ngw;
        if (nrow < T) { const f32x4* xr = (const f32x4*)((nrow < NLAT ? hx : hcx) + (size_t)nrow * D) + C.lane;
#pragma unroll
            for (int j = 0; j < 4; ++j) vn[j] = xr[64 * j]; }
        float mean, rstd; ln_stats(v, mean, rstd, C.lane);
        const int r = row < NLAT ? (row >> 12) : 4; const LAS f32x4* sh = (const LAS f32x4*)(C.lds + r * 4096) + C.lane; const LAS f32x4* sc = (const LAS f32x4*)(C.lds + 20480 + r * 4096) + C.lane;
        u32x2* o = (u32x2*)(U + (size_t)row * D) + C.lane;
#pragma unroll
        for (int j = 0; j < 4; ++j) { const f32x4 y = (v[j] - mean) * rstd * sc[64 * j] + sh[64 * j]; u32x2 w; w.x = pk2(y.x, y.y); w.y = pk2(y.z, y.w); o[64 * j] = w; }
    }
}
__device__ __forceinline__ bool nb_valid(int row, int d) {
    if (row < NLAT) { const int s = (row & (SEQ - 1)) + d; return s >= 0 && s < SEQ; }
    const int i = ((row - NLAT) & (CTX - 1)) + d; return i >= 0 && i < CTX;
}
__device__ __forceinline__ void conv_chunk(Ctx& C, const bf16_t* P, bf16_t* SC, const float* scw, int chunk) {
#pragma unroll 2
    for (int u = 0; u < 4; ++u) {
        const int it = chunk * 2048 + C.tid + 512 * u; const int row = it >> 6, c0 = (it & 63) * 8;
        float acc[8], sb[8];
#pragma unroll
        for (int e = 0; e < 8; ++e) acc[e] = 0.f;
#pragma unroll
        for (int k = 0; k < 3; ++k) { const int d = k - 1; if (nb_valid(row, d)) { float g[8], x[8]; unpack8(*(const u32x4*)(P + (size_t)(row + d) * PT + C_SCG + c0), g); unpack8(*(const u32x4*)(P + (size_t)(row + d) * PT + C_SX + c0), x);
#pragma unroll
                for (int e = 0; e < 8; ++e) acc[e] += scw[k * 512 + c0 + e] * (g[e] * x[e]); } }
        unpack8(*(const u32x4*)(P + (size_t)row * PT + C_SB + c0), sb);
#pragma unroll
        for (int e = 0; e < 8; ++e) acc[e] *= sb[e];
        *(u32x4*)(SC + (size_t)row * 2048 + c0) = pack8(acc);
    }
}
constexpr int A3_CK = 0, A3_CV = 32768, A3_LK = 66560, A3_RP = 133120, A3_MG = 135168, A3_QS = 152064, A3_CVS = 528, A3_LVS = 1040;
__device__ __forceinline__ int a3_f(int kk) { return (((kk >> 3) & 3) << 1) | ((kk >> 1) & 1); }
template <bool LOCAL>
__device__ __forceinline__ void attn_item(Ctx& C, const bf16_t* P, const bf16_t* VT, bf16_t* O, const float* rpb_l, int b, int hd, int r, int qrow_base, int* ctr, LAS int* qslot) {
    int nxq = 0; if (C.tid == 0) nxq = atomicAdd(ctr, 1);
    const int tid = C.tid, lane = C.lane, w = C.wave, grp = w & 3, kh = w >> 2;
    const int q = lane & 15, g = lane >> 4, i = lane & 15;
    const int r0 = LOCAL ? min(max(r - 4, 0), 56) : 0; const int w0 = LOCAL ? (grp == 0 ? 0 : grp == 1 ? 8 : grp == 2 ? 24 : 32) : 0;
    LAS unsigned char* L = C.lds;
    constexpr int NA = LOCAL ? 12 : 4;
    u32x4 st[NA];
#pragma unroll
    for (int u = 0; u < 4; ++u) { const int p = tid + 512 * u, k = p >> 3, c = (p & 7) ^ a3_f(k); st[u] = *(const u32x4*)(P + (size_t)(NLAT + b * CTX + k) * PT + C_K + hd * 64 + 8 * c); }
    if (LOCAL) {
#pragma unroll
        for (int u = 0; u < 8; ++u) { const int p = tid + 512 * u, kk = p >> 3, c = (p & 7) ^ a3_f(kk); const int row = b * SEQ + (r0 + (kk >> 6)) * 64 + (kk & 63);
            st[4 + u] = *(const u32x4*)(P + (size_t)row * PT + C_K + hd * 64 + 8 * c); } }
    float rpv = 0.f; if (LOCAL && tid < 465) rpv = rpb_l[hd * 465 + tid];
    const int qrow0 = qrow_base + 16 * grp;
    bf16x8 Qf[2];
#pragma unroll
    for (int ks = 0; ks < 2; ++ks) { float t8[8]; unpack8(*(const u32x4*)(P + (size_t)(qrow0 + q) * PT + C_Q + hd * 64 + 32 * ks + 8 * g), t8);
#pragma unroll
        for (int j = 0; j < 8; ++j) t8[j] *= 0.125f;
        Qf[ks] = __builtin_bit_cast(bf16x8, pack8(t8)); }
#pragma unroll
    for (int u = 0; u < 4; ++u) *(LAS u32x4*)(L + A3_CK + (tid + 512 * u) * 16) = st[u];
    if (LOCAL) {
#pragma unroll
        for (int u = 0; u < 8; ++u) *(LAS u32x4*)(L + A3_LK + (tid + 512 * u) * 16) = st[4 + u];
        if (tid < 465) ((LAS float*)(L + A3_RP))[tid] = rpv; }
    __syncthreads();
#pragma unroll
    for (int u = 0; u < 4; ++u) { const int p = tid + 512 * u, dh = p >> 5, ch = p & 31; st[u] = *(const u32x4*)(VT + (size_t)(hd * 64 + dh) * T + NLAT + b * CTX + 8 * ch); }
    if (LOCAL) {
#pragma unroll
        for (int u = 0; u < 8; ++u) { const int p = tid + 512 * u, dh = p >> 6, ch = p & 63; const int tok = b * SEQ + (r0 + (ch >> 3)) * 64 + 8 * (ch & 7);
            st[4 + u] = *(const u32x4*)(VT + (size_t)(hd * 64 + dh) * T + tok); } }
    constexpr int NT = LOCAL ? 16 : 8;
    f32x4 S[NT];
    const int koff = 8 * (i >> 2) + (i & 3);
#pragma unroll
    for (int j = 0; j < 4; ++j)
#pragma unroll
        for (int tt = 0; tt < 2; ++tt) { const int kk = 128 * kh + 32 * j + koff + 4 * tt, fs = a3_f(kk); const LAS unsigned char* kb = L + A3_CK + kk * 128;
            f32x4 a = (f32x4){0.f, 0.f, 0.f, 0.f};
            a = __builtin_amdgcn_mfma_f32_16x16x32_bf16(*(const LAS bf16x8*)(kb + ((g ^ fs) << 4)), Qf[0], a, 0, 0, 0);
            a = __builtin_amdgcn_mfma_f32_16x16x32_bf16(*(const LAS bf16x8*)(kb + (((g + 4) ^ fs) << 4)), Qf[1], a, 0, 0, 0);
            S[2 * j + tt] = a; }
    if (LOCAL) {
#pragma unroll
        for (int j = 0; j < 4; ++j)
#pragma unroll
            for (int tt = 0; tt < 2; ++tt) { const int kk = (4 * kh + j) * 64 + w0 + koff + 4 * tt, fs = a3_f(kk); const LAS unsigned char* kb = L + A3_LK + kk * 128;
                f32x4 a = (f32x4){0.f, 0.f, 0.f, 0.f};
                a = __builtin_amdgcn_mfma_f32_16x16x32_bf16(*(const LAS bf16x8*)(kb + ((g ^ fs) << 4)), Qf[0], a, 0, 0, 0);
                a = __builtin_amdgcn_mfma_f32_16x16x32_bf16(*(const LAS bf16x8*)(kb + (((g + 4) ^ fs) << 4)), Qf[1], a, 0, 0, 0);
                S[8 + 2 * j + tt] = a; }
        const int c = 16 * grp + q, cs = min(max(c - 8, 0), 48);
        const int vb = w0 + 8 * g - cs;
        const LAS float* bp = (const LAS float*)(L + A3_RP) + (r0 - r + 7 + 4 * kh) * 31 + (w0 + 8 * g - c + 15);
#pragma unroll
        for (int j = 0; j < 4; ++j)
#pragma unroll
            for (int tt = 0; tt < 2; ++tt)
#pragma unroll
                for (int rg = 0; rg < 4; ++rg) { const bool ok = (unsigned)(vb + rg + 4 * tt) < 16u; const float v = S[8 + 2 * j + tt][rg] + bp[j * 31 + rg + 4 * tt];
                    S[8 + 2 * j + tt][rg] = ok ? v : -1e30f; }
    }
    float mx = -1e30f;
#pragma unroll
    for (int t = 0; t < NT; ++t) mx = fmaxf(fmaxf(mx, fmaxf(S[t][0], S[t][1])), fmaxf(S[t][2], S[t][3]));
    mx = fmaxf(mx, bperm(lane ^ 16, mx)); mx = fmaxf(mx, bperm(lane ^ 32, mx));
    float ls = 0.f;
#pragma unroll
    for (int t = 0; t < NT; ++t)
#pragma unroll
        for (int rg = 0; rg < 4; ++rg) { const float pe = __expf(S[t][rg] - mx); S[t][rg] = pe; ls += pe; }
    ls += bperm(lane ^ 16, ls); ls += bperm(lane ^ 32, ls);
    __syncthreads();
    if (tid == 0) *qslot = nxq;
#pragma unroll
    for (int u = 0; u < 4; ++u) { const int p = tid + 512 * u; *(LAS u32x4*)(L + A3_CV + (p >> 5) * A3_CVS + (p & 31) * 16) = st[u]; }
    if (LOCAL) {
#pragma unroll
        for (int u = 0; u < 8; ++u) { const int p = tid + 512 * u; *(LAS u32x4*)(L + A3_LK + (p >> 6) * A3_LVS + (p & 63) * 16) = st[4 + u]; } }
    __syncthreads();
    f32x4 Oa[4];
#pragma unroll
    for (int dt = 0; dt < 4; ++dt) Oa[dt] = (f32x4){0.f, 0.f, 0.f, 0.f};
#pragma unroll
    for (int j = 0; j < 4; ++j) {
        float p8[8] = {S[2 * j][0], S[2 * j][1], S[2 * j][2], S[2 * j][3], S[2 * j + 1][0], S[2 * j + 1][1], S[2 * j + 1][2], S[2 * j + 1][3]};
        const bf16x8 pk = __builtin_bit_cast(bf16x8, pack8(p8));
#pragma unroll
        for (int dt = 0; dt < 4; ++dt) Oa[dt] = __builtin_amdgcn_mfma_f32_16x16x32_bf16(*(const LAS bf16x8*)(L + A3_CV + (16 * dt + i) * A3_CVS + (128 * kh + 32 * j + 8 * g) * 2), pk, Oa[dt], 0, 0, 0);
    }
    if (LOCAL) {
#pragma unroll
        for (int j = 0; j < 4; ++j) {
            float p8[8] = {S[8 + 2 * j][0], S[8 + 2 * j][1], S[8 + 2 * j][2], S[8 + 2 * j][3], S[9 + 2 * j][0], S[9 + 2 * j][1], S[9 + 2 * j][2], S[9 + 2 * j][3]};
            const bf16x8 pk = __builtin_bit_cast(bf16x8, pack8(p8));
#pragma unroll
            for (int dt = 0; dt < 4; ++dt) Oa[dt] = __builtin_amdgcn_mfma_f32_16x16x32_bf16(*(const LAS bf16x8*)(L + A3_LK + (16 * dt + i) * A3_LVS + ((4 * kh + j) * 64 + w0 + 8 * g) * 2), pk, Oa[dt], 0, 0, 0);
        }
    }
    LAS unsigned char* MG = L + A3_MG + grp * 4224;
    if (kh == 1) {
#pragma unroll
        for (int dt = 0; dt < 4; ++dt) *(LAS f32x4*)(MG + (q * 64 + 16 * dt + 4 * g) * 4) = Oa[dt];
        if (g == 0) { ((LAS float*)(MG + 4096))[2 * q] = mx; ((LAS float*)(MG + 4096))[2 * q + 1] = ls; } }
    __syncthreads();
    if (kh == 0) {
        const float m1 = ((const LAS float*)(MG + 4096))[2 * q], l1 = ((const LAS float*)(MG + 4096))[2 * q + 1];
        const float m = fmaxf(mx, m1), f0 = __expf(mx - m), f1 = __expf(m1 - m); const float inv = 1.0f / (ls * f0 + l1 * f1);
#pragma unroll
        for (int dt = 0; dt < 4; ++dt) { const f32x4 o1 = *(const LAS f32x4*)(MG + (q * 64 + 16 * dt + 4 * g) * 4); const f32x4 o = (Oa[dt] * f0 + o1 * f1) * inv;
            u32x2 wv; wv.x = pk2(o[0], o[1]); wv.y = pk2(o[2], o[3]);
            *(u32x2*)(O + (size_t)(qrow0 + q) * 2048 + hd * 64 + 16 * dt + 4 * g) = wv; } }
}
__device__ __forceinline__ void phase_attn3(Ctx& C, int l, bool with_ctx) {
    PHASE_BEGIN(C); PIN_S(l);
    const bf16_t* P = WSP(bf16_t, WS_P); const bf16_t* VT = WSP(bf16_t, WS_VT); bf16_t* O = WSP(bf16_t, WS_CAT); const float* rpb = INP(8) + (size_t)l * 8 * 465;
    LAS int* qslot = (LAS int*)(C.lds + A3_QS);
    const int xcd = C.bid & 7; int* ctr = WSP(int, WS_CTL) + 128 + l * 8 + xcd;
    const int nper = 256 + (with_ctx ? 16 : 0);
    const int nconv = ((l == 1 ? NLAT : T) / 32) / 8;
    bf16_t* SC = WSP(bf16_t, WS_CAT) + 512; const float* scw = INP(12) + (size_t)l * 3 * 512;
    __syncthreads();
    if (C.tid == 0) *qslot = atomicAdd(ctr, 1);
    for (;;) {
        __syncthreads();
        const int j = *qslot; if (j >= nper + nconv) break;
        if (j >= nper) { int nxq = 0; if (C.tid == 0) nxq = atomicAdd(ctr, 1);
            conv_chunk(C, P, SC, scw, (j - nper) * 8 + xcd);
            __syncthreads(); if (C.tid == 0) *qslot = nxq; continue; }
        if (j < 256) { const int rr = 32 * xcd + (j >> 3), hd = j & 7; const int b = rr >> 6, r = rr & 63;
            attn_item<true>(C, P, VT, O, rpb, b, hd, r, b * SEQ + r * 64, ctr, qslot); }
        else { const int cidx = 16 * xcd + (j - 256); const int b = cidx >> 5, hd = (cidx >> 2) & 7, ch = cidx & 3;
            attn_item<false>(C, P, VT, O, rpb, b, hd, 0, NLAT + b * CTX + 64 * ch, ctr, qslot); }
    }
}
typedef float f32x16 __attribute__((ext_vector_type(16)));
__device__ __forceinline__ int lru_row(int b, int d, int p) {
    if (p < CTX) return NLAT + b * CTX + (d ? CTX - 1 - p : p);
    const int s = p - CTX; return b * SEQ + (d ? SEQ - 1 - s : s);
}
__device__ __forceinline__ float fsigmoid(float x) { return __builtin_amdgcn_rcpf(1.0f + __expf(-x)); }
__device__ __forceinline__ void phase_lru(Ctx& C, int l) {
    PHASE_BEGIN(C); PIN_S(l);
    const bf16_t* P = WSP(bf16_t, WS_P); bf16_t* LR = WSP(bf16_t, WS_CAT) + 1024;
    const float* lcw = INP(13) + (size_t)l * 4 * 512; const float* lcb = INP(14) + (size_t)l * 512; const float* lam = INP(15) + (size_t)l * 2 * 512;
    const float* wr_ = INP(16) + (size_t)l * 2 * 8 * 4096; const float* br = INP(17) + (size_t)l * 2 * 512;
    const float* wi_ = INP(18) + (size_t)l * 2 * 8 * 4096; const float* bi = INP(19) + (size_t)l * 2 * 512;
    LAS float* cw = (LAS float*)C.lds;
    LAS f32x2* agg = (LAS f32x2*)(C.lds + 2048);
    const int lane = C.lane, w = C.wave, col = lane & 31, hi = lane >> 5;
    LAS unsigned char* Llx = C.lds + 8192 + w * 10240; LAS unsigned char* Llg = Llx + 5120; LAS unsigned char* Lout = Llx + 7680;
    for (int item = C.bid; item < 128; item += C.nb) {
        const int b = item >> 5, d = (item >> 4) & 1, n = (item >> 1) & 7, half = item & 1;
        __syncthreads();
        if (C.tid < 320) cw[C.tid] = C.tid < 256 ? lcw[(C.tid >> 6) * 512 + n * 64 + (C.tid & 63)] : lcb[n * 64 + (C.tid - 256)];
        __syncthreads();
        const int e = n * 64 + half * 32 + col;
        bf16x8 Br[4], Bi[4], Bid[2];
#pragma unroll
        for (int ks = 0; ks < 4; ++ks) { float vr[8], vi[8];
#pragma unroll
            for (int j = 0; j < 8; ++j) { const size_t o = ((size_t)(d * 8 + n) * 64 + 16 * ks + 8 * hi + j) * 64 + half * 32 + col; vr[j] = wr_[o]; vi[j] = wi_[o]; }
            Br[ks] = __builtin_bit_cast(bf16x8, pack8(vr)); Bi[ks] = __builtin_bit_cast(bf16x8, pack8(vi)); }
#pragma unroll
        for (int q = 0; q < 2; ++q) { float v1[8];
#pragma unroll
            for (int j = 0; j < 8; ++j) v1[j] = (16 * q + 8 * hi + j == col) ? 1.0f : 0.0f;
            Bid[q] = __builtin_bit_cast(bf16x8, pack8(v1)); }
        const float cl2 = -8.0f * log1pf(expf(-lam[d * 512 + e])) * 1.4426950408889634f;
        const float brv = br[d * 512 + e], biv = bi[d * 512 + e];
#define LRU_RLO(sc_) ((sc_) == 0 ? NLAT + b * CTX + (d ? 224 - w * 32 : w * 32) : b * SEQ + (d ? 4064 - (((sc_) - 1) * 256 + w * 32) : ((sc_) - 1) * 256 + w * 32))
#define LRU_LOAD(sc_) do { const int rlo_ = LRU_RLO(sc_); const int slo_ = (sc_) == 0 ? NLAT + b * CTX : b * SEQ, shi_ = (sc_) == 0 ? slo_ + CTX : slo_ + SEQ; \
        _Pragma("unroll") for (int u = 0; u < 5; ++u) { const int q_ = lane + 64 * u; const int t_ = q_ >> 3; const int row_ = rlo_ - 2 + t_; const bool ok_ = (q_ < 280) && row_ >= slo_ && row_ < shi_; \
            const int rc_ = ok_ ? row_ : rlo_; const u32x4 v_ = *(const u32x4*)(P + (size_t)rc_ * PT + C_LX + n * 64 + 8 * (q_ & 7)); lxr[u] = ok_ ? v_ : (u32x4){0u, 0u, 0u, 0u}; } \
        _Pragma("unroll") for (int u = 0; u < 2; ++u) { const int q_ = lane + 64 * u; lgr[u] = *(const u32x4*)(P + (size_t)(rlo_ + (q_ >> 2)) * PT + C_LG + n * 64 + half * 32 + 8 * (q_ & 3)); } } while (0)
        u32x4 lxr[5], lgr[2];
        LRU_LOAD(0);
        float run = 0.f;
#pragma unroll 1
        for (int sc = 0; sc < 17; ++sc) {
            const int rlo = LRU_RLO(sc);
#pragma unroll
            for (int u = 0; u < 5; ++u) { const int q_ = lane + 64 * u; if (q_ < 280) *(LAS u32x4*)(Llx + (q_ >> 3) * 144 + (q_ & 7) * 16) = lxr[u]; }
#pragma unroll
            for (int u = 0; u < 2; ++u) { const int q_ = lane + 64 * u; *(LAS u32x4*)(Llg + (q_ >> 2) * 80 + (q_ & 3) * 16) = lgr[u]; }
            if (sc + 1 < 17) LRU_LOAD(sc + 1);
            const int pa = 16 * ((col >> 2) & 1) + 4 * (col >> 3) + (col & 3);
            const int rho = d ? 31 - pa : pa;
            bf16x8 A[4];
#pragma unroll
            for (int ks = 0; ks < 4; ++ks) { const int k0 = 16 * ks + 8 * hi; float x[8];
#pragma unroll
                for (int j = 0; j < 8; ++j) x[j] = cw[256 + k0 + j];
#pragma unroll
                for (int tap = 0; tap < 4; ++tap) { float v8[8]; unpack8(*(const LAS u32x4*)(Llx + (rho + tap) * 144 + (2 * ks + hi) * 16), v8);
#pragma unroll
                    for (int j = 0; j < 8; ++j) x[j] += cw[tap * 64 + k0 + j] * v8[j]; }
                A[ks] = __builtin_bit_cast(bf16x8, pack8(x)); }
            f32x16 aR, aI, aX;
#pragma unroll
            for (int r = 0; r < 16; ++r) { aR[r] = brv; aI[r] = biv; aX[r] = 0.f; }
#pragma unroll
            for (int ks = 0; ks < 4; ++ks) { aR = __builtin_amdgcn_mfma_f32_32x32x16_bf16(A[ks], Br[ks], aR, 0, 0, 0); aI = __builtin_amdgcn_mfma_f32_32x32x16_bf16(A[ks], Bi[ks], aI, 0, 0, 0); }
            { const bf16x8 Ax0 = half ? A[2] : A[0], Ax1 = half ? A[3] : A[1];
              aX = __builtin_amdgcn_mfma_f32_32x32x16_bf16(Ax0, Bid[0], aX, 0, 0, 0); aX = __builtin_amdgcn_mfma_f32_32x32x16_bf16(Ax1, Bid[1], aX, 0, 0, 0); }
            float hl[16], ac[16]; float h = 0.f, Ac = 1.f;
#pragma unroll
            for (int r = 0; r < 16; ++r) {
                const float rr = fsigmoid(aR[r]), ig = fsigmoid(aI[r]); const float la2 = cl2 * rr; const float a = __builtin_amdgcn_exp2f(la2);
                const float x2 = la2 * 1.3862943611198906f;
                const float poly = -x2 * (1.0f + x2 * (0.5f + x2 * (0.16666667f + x2 * (0.041666668f + x2 * (0.0083333338f + x2 * 0.0013888889f)))));
                const float em = x2 > -0.3f ? poly : 1.0f - a * a;
                const float bb = __builtin_amdgcn_sqrtf(em) * (ig * aX[r]);
                h = a * h + bb; Ac *= a; hl[r] = h; ac[r] = Ac;
            }
            const float A0 = bperm(col, Ac), h0 = bperm(col, h), A1 = bperm(col + 32, Ac), h1 = bperm(col + 32, h);
            const int par = sc & 1;
            if (hi == 0) agg[(par * 8 + w) * 32 + col] = (f32x2){A0 * A1, h1 + A1 * h0};
            __syncthreads();
            float carry = run, cin = 0.f;
#pragma unroll
            for (int ww = 0; ww < 8; ++ww) { const f32x2 g = agg[(par * 8 + ww) * 32 + col]; if (ww == w) cin = carry; carry = g.y + g.x * carry; }
            run = carry;
            const float cl = hi ? (h0 + A0 * cin) : cin;
#pragma unroll
            for (int r = 0; r < 16; ++r) { const int rr_ = d ? 31 - (16 * hi + r) : 16 * hi + r;
                const float lgv = bf2f(*(const LAS unsigned short*)(Llg + rr_ * 80 + col * 2)); const float hf = hl[r] + ac[r] * cl;
                const float u = 0.7978845608028654f * (lgv + 0.044715f * lgv * lgv * lgv);
                *(LAS unsigned short*)(Lout + rr_ * 80 + col * 2) = (unsigned short)f2bf(lgv * fsigmoid(2.0f * u) * hf); }
#pragma unroll
            for (int u = 0; u < 2; ++u) { const int q_ = lane + 64 * u; const u32x4 o = *(const LAS u32x4*)(Lout + (q_ >> 2) * 80 + (q_ & 3) * 16);
                *(u32x4*)(LR + (size_t)(rlo + (q_ >> 2)) * 2048 + d * 512 + n * 64 + half * 32 + 8 * (q_ & 3)) = o; }
        }
#undef LRU_RLO
#undef LRU_LOAD
    }
}
__device__ __forceinline__ void phase_ln1(Ctx& C, int l, int nrows) {
    PHASE_BEGIN(C); PIN_S(l);
    const bf16_t* V = WSP(bf16_t, WS_V); float* H = WSP(float, WS_H); bf16_t* U = WSP(bf16_t, WS_U); const float* mod = WSP(float, WS_MOD) + (size_t)l * 5 * 6144;
    const float* g1 = INP(22) + l * D; const float* b1 = INP(23) + l * D; const float* rw = INP(24) + (size_t)l * D * 32; const float* rb = INP(25) + l * 32;
    int* topi = WSP(int, WS_SMALL); float* topp = WSP(float, WS_SMALL + 512 * 1024); int* cnt = WSP(int, WS_CTL) + 1024 + l * 1024;
    int* epos = WSP(int, WS_SMALL + 1 * MiB); int* etok = WSP(int, WS_ETOK) + (size_t)l * 32 * ECAP;
    LAS float* Ut = (LAS float*)C.lds;
    LAS float* Pt = (LAS float*)(C.lds + 65792);
    LAS float* Lg = (LAS float*)(C.lds + 65792 + 16384);
    constexpr int L1_SH = 86016, L1_SC = 106496, L1_G1 = 126976, L1_B1 = 131072;
    LAS int* lcnt = (LAS int*)(C.lds + LDS_LN1); LAS int* lbase = lcnt + 32; LAS int* rec = lcnt + 64;
    __syncthreads();
    if (C.tid < 32) lcnt[C.tid] = 0;
    for (int r = 0; r < 5; ++r) { lds_vec_copy(C, L1_SH + r * 4096, mod + r * 6144 + 3 * D, 0.f); lds_vec_copy(C, L1_SC + r * 4096, mod + r * 6144 + 4 * D, 1.0f); }
    lds_vec_copy(C, L1_G1, g1, 0.f); lds_vec_copy(C, L1_B1, b1, 0.f);
    __syncthreads();
    const int lane = C.lane, w = C.wave, e = lane & 31, hr = lane >> 5;
    float Bf[32][2];
#pragma unroll
    for (int s_ = 0; s_ < 32; ++s_)
#pragma unroll
        for (int t = 0; t < 2; ++t) Bf[s_][t] = rw[(size_t)(128 * w + 4 * s_ + (lane >> 4)) * 32 + 16 * t + (lane & 15)];
    const float rbe = rb[e];
    const int nbatch = nrows / 16;
    u32x2 vn[2][4];
#define LN1_LOADV(q_, row_) do { _Pragma("unroll") for (int j = 0; j < 4; ++j) vn[q_][j] = ((const u32x2*)(V + (size_t)(row_) * D) + lane)[64 * j]; } while (0)
#pragma unroll
    for (int q = 0; q < 2; ++q)
#pragma unroll
        for (int j = 0; j < 4; ++j) vn[q][j] = (u32x2){0u, 0u};
    int bt = C.bid, ri = 0;
    if (bt < nbatch) { LN1_LOADV(0, bt * 16 + 2 * w); LN1_LOADV(1, bt * 16 + 2 * w + 1); }
    while (bt < nbatch) {
        const int nbt = bt + C.nb;
        f32x4 vv[2][4];
#pragma unroll
        for (int q = 0; q < 2; ++q)
#pragma unroll
            for (int j = 0; j < 4; ++j) vv[q][j] = bf4(vn[q][j]);
        { const int pb = nbt < nbatch ? nbt : bt;
          LN1_LOADV(0, pb * 16 + 2 * w); LN1_LOADV(1, pb * 16 + 2 * w + 1); }
#pragma unroll
        for (int q = 0; q < 2; ++q) {
            const int row = bt * 16 + 2 * w + q;
            f32x4 v[4];
#pragma unroll
            for (int j = 0; j < 4; ++j) v[j] = vv[q][j];
            float mean, rstd; ln_stats(v, mean, rstd, lane);
#pragma unroll
            for (int j = 0; j < 4; ++j) v[j] = (v[j] - mean) * rstd * ((const LAS f32x4*)(C.lds + L1_G1))[lane + 64 * j] + ((const LAS f32x4*)(C.lds + L1_B1))[lane + 64 * j];
            ln_stats(v, mean, rstd, lane);
            const int r = row < NLAT ? (row >> 12) : 4; const LAS f32x4* sh = (const LAS f32x4*)(C.lds + L1_SH + r * 4096) + lane; const LAS f32x4* sc = (const LAS f32x4*)(C.lds + L1_SC + r * 4096) + lane;
            u32x2* o = (u32x2*)(U + (size_t)row * D) + lane;
#pragma unroll
            for (int j = 0; j < 4; ++j) { v[j] = (v[j] - mean) * rstd * sc[64 * j] + sh[64 * j]; u32x2 wv; wv.x = pk2(v[j].x, v[j].y); wv.y = pk2(v[j].z, v[j].w); o[64 * j] = wv;
                *(LAS f32x4*)(Ut + (2 * w + q) * 1028 + 4 * lane + 256 * j) = v[j]; }
        }
        __syncthreads();
        { f32x4 a0 = (f32x4){0.f, 0.f, 0.f, 0.f}, a1 = a0;
          const LAS float* ap = Ut + (lane & 15) * 1028 + 128 * w + (lane >> 4);
#pragma unroll
          for (int s_ = 0; s_ < 32; ++s_) { const float av = ap[4 * s_];
              a0 = __builtin_amdgcn_mfma_f32_16x16x4f32(av, Bf[s_][0], a0, 0, 0, 0); a1 = __builtin_amdgcn_mfma_f32_16x16x4f32(av, Bf[s_][1], a1, 0, 0, 0); }
          LAS float* pp = Pt + (w * 16 + 4 * (lane >> 4)) * 32 + (lane & 15);
#pragma unroll
          for (int rg = 0; rg < 4; ++rg) { pp[rg * 32] = a0[rg]; pp[rg * 32 + 16] = a1[rg]; } }
        __syncthreads();
        { const int q = 2 * w + hr, row = bt * 16 + q;
          float acc = rbe;
#pragma unroll
          for (int ww = 0; ww < 8; ++ww) acc += Pt[(ww * 16 + q) * 32 + e];
          Lg[q * 32 + e] = acc;
          asm volatile("s_waitcnt lgkmcnt(0)" ::: "memory");
          int rank = 0;
#pragma unroll
          for (int g = 0; g < 8; ++g) { const f32x4 lq = *(const LAS f32x4*)(Lg + q * 32 + 4 * g);
#pragma unroll
              for (int j = 0; j < 4; ++j) rank += (lq[j] > acc || (lq[j] == acc && 4 * g + j < e)) ? 1 : 0; }
          const bool sel = rank < 4;
          const float t0c = (rank == 0) ? acc : -3.0e38f;
          float t0 = t0c;
#pragma unroll
          for (int o_ = 1; o_ < 32; o_ <<= 1) t0 = fmaxf(t0, bperm(lane ^ o_, t0));
          const float pe = sel ? __expf(acc - t0) : 0.f;
          float psum = pe;
#pragma unroll
          for (int o_ = 1; o_ < 32; o_ <<= 1) psum += bperm(lane ^ o_, psum);
          if (sel) {
              topi[(size_t)row * 4 + rank] = e; topp[(size_t)row * 4 + rank] = pe * __builtin_amdgcn_rcpf(psum);
              const int lpos = __hip_atomic_fetch_add(lcnt + e, 1, __ATOMIC_RELAXED, __HIP_MEMORY_SCOPE_WORKGROUP);
              rec[((w * 2 + hr) * 8 + ri) * 4 + rank] = (e << 16) | lpos;
          } }
        ++ri; bt = nbt;
    }
#undef LN1_LOADV
    __syncthreads();
    if (C.tid < 32) lbase[C.tid] = atomicAdd(cnt + 32 * C.tid, lcnt[C.tid]);
    __syncthreads();
    if ((lane & 31) < 4) { const int k = lane & 31; int bt2 = C.bid;
        for (int i = 0; i < ri; ++i, bt2 += C.nb) { const int row = bt2 * 16 + 2 * w + hr; const int rr = rec[((w * 2 + hr) * 8 + i) * 4 + k]; const int ek = rr >> 16, pos = lbase[ek] + (rr & 0xffff);
            etok[(size_t)ek * ECAP + pos] = row; epos[(size_t)row * 4 + k] = pos; } }
}
__device__ __forceinline__ void build_blk(Ctx& C, int l) {
    LAS int* blk = (LAS int*)(C.lds + 131072); LAS int* cl = blk + 64; LAS int* nbk = blk + 128; const int* cnt = WSP(int, WS_CTL) + 1024 + l * 1024;
    __syncthreads();
    if (C.tid < 32) { const int c = __hip_atomic_load(cnt + 32 * C.tid, __ATOMIC_RELAXED, __HIP_MEMORY_SCOPE_AGENT); cl[C.tid] = c; nbk[C.tid] = (c + 255) >> 8; }
    __syncthreads();
    if (C.tid < 33) { int s_ = 0; for (int e = 0; e < C.tid; ++e) s_ += nbk[e]; blk[C.tid] = s_; }
    __syncthreads();
}
__device__ __forceinline__ void phase_combine(Ctx& C, int l, int nrows, bool last) {
    PHASE_BEGIN(C); PIN_S(l);
    bf16_t* U = WSP(bf16_t, WS_U); const float* modn = WSP(float, WS_MOD) + (size_t)(l + 1) * 5 * 6144;
    float* H = WSP(float, WS_H); const bf16_t* Y = WSP(bf16_t, WS_RA); const float* mod = WSP(float, WS_MOD) + (size_t)l * 5 * 6144;
    const float* g2 = INP(30) + l * D; const float* b2 = INP(31) + l * D; const float* topp = WSP(float, WS_SMALL + 512 * 1024); const int* epos = WSP(int, WS_SMALL + 1 * MiB); const int* topi = WSP(int, WS_SMALL);
    build_blk(C, l); const LAS int* blk = (const LAS int*)(C.lds + 131072);
    constexpr int CB_G1 = 0, CB_B1 = 4096, CB_G2 = 8192, CB_B2 = 12288, CB_GG = 16384, CB_SH = 36864, CB_SC = 57344;
    lds_vec_copy(C, CB_G1, INP(22) + l * D, 0.f); lds_vec_copy(C, CB_B1, INP(23) + l * D, 0.f); lds_vec_copy(C, CB_G2, g2, 0.f); lds_vec_copy(C, CB_B2, b2, 0.f);
    for (int r = 0; r < 5; ++r) { lds_vec_copy(C, CB_GG + r * 4096, mod + r * 6144 + 5 * D, 0.f);
        if (!last) { lds_vec_copy(C, CB_SH + r * 4096, modn + r * 6144, 0.f); lds_vec_copy(C, CB_SC + r * 4096, modn + r * 6144 + D, 1.0f); } }
    __syncthreads();
    const bf16_t* Vb = WSP(bf16_t, WS_V);
#define CMB_IDX(row_, sl_, te_, pp_) do { sl_ = *(const int4*)(epos + (size_t)(row_) * 4); te_ = *(const int4*)(topi + (size_t)(row_) * 4); pp_ = *(const f32x4*)(topp + (size_t)(row_) * 4); } while (0)
#define CMB_DATA(row_, sl_, te_, yd_, hd_) do { const int s0_ = blk[te_.x] * 256 + sl_.x, s1_ = blk[te_.y] * 256 + sl_.y, s2_ = blk[te_.z] * 256 + sl_.z, s3_ = blk[te_.w] * 256 + sl_.w; \
        _Pragma("unroll") for (int j = 0; j < 4; ++j) { yd_[0][j] = ((const u32x2*)(Y + (size_t)s0_ * D) + C.lane)[64 * j]; yd_[1][j] = ((const u32x2*)(Y + (size_t)s1_ * D) + C.lane)[64 * j]; \
            yd_[2][j] = ((const u32x2*)(Y + (size_t)s2_ * D) + C.lane)[64 * j]; yd_[3][j] = ((const u32x2*)(Y + (size_t)s3_ * D) + C.lane)[64 * j]; hd_[j] = ((const u32x2*)(Vb + (size_t)(row_) * D) + C.lane)[64 * j]; } } while (0)
    int row = C.gw;
    int4 slA, teA, slB, teB; f32x4 ppA, ppB, ppC;
    slA = make_int4(0, 0, 0, 0); teA = slA; slB = slA; teB = slA; ppA = (f32x4){0.f, 0.f, 0.f, 0.f}; ppB = ppA; ppC = ppA;
    u32x2 yc[4][4], yn[4][4]; u32x2 hc[4], hn[4];
    if (row < nrows) { CMB_IDX(row, slA, teA, ppA); }
    if (row + C.ngw < nrows) { CMB_IDX(row + C.ngw, slB, teB, ppB); }
    if (row < nrows) { CMB_DATA(row, slA, teA, yc, hc); }
    ppC = ppA;
    while (row < nrows) {
        const int nrow = row + C.ngw, nnrow = nrow + C.ngw;
        if (nrow < nrows) { CMB_DATA(nrow, slB, teB, yn, hn); }
        const f32x4 ppN = ppB;
        if (nnrow < nrows) { CMB_IDX(nnrow, slB, teB, ppB); }
        const float pps[4] = {ppC.x, ppC.y, ppC.z, ppC.w};
        f32x4 y[4];
#pragma unroll
        for (int j = 0; j < 4; ++j) y[j] = (f32x4){0.f, 0.f, 0.f, 0.f};
#pragma unroll
        for (int k = 0; k < 4; ++k)
#pragma unroll
            for (int j = 0; j < 4; ++j) { const u32x2 w = yc[k][j]; y[j].x += pps[k] * bf2f(w.x & 0xffffu); y[j].y += pps[k] * bf2f(w.x >> 16); y[j].z += pps[k] * bf2f(w.y & 0xffffu); y[j].w += pps[k] * bf2f(w.y >> 16); }
        const int r = row < NLAT ? (row >> 12) : 4; const LAS f32x4* gg = (const LAS f32x4*)(C.lds + CB_GG + r * 4096) + C.lane;
        f32x4* hr = (f32x4*)(H + (size_t)row * D) + C.lane; f32x4 v[4];
#pragma unroll
        for (int j = 0; j < 4; ++j) v[j] = bf4(hc[j]);
        float mean, rstd; ln_stats(v, mean, rstd, C.lane);
#pragma unroll
        for (int j = 0; j < 4; ++j) { const f32x4 h1 = (v[j] - mean) * rstd * ((const LAS f32x4*)(C.lds + CB_G1))[C.lane + 64 * j] + ((const LAS f32x4*)(C.lds + CB_B1))[C.lane + 64 * j]; v[j] = h1 * ALPHA + gg[64 * j] * y[j]; }
        ln_stats(v, mean, rstd, C.lane);
#pragma unroll
        for (int j = 0; j < 4; ++j) v[j] = (v[j] - mean) * rstd * ((const LAS f32x4*)(C.lds + CB_G2))[C.lane + 64 * j] + ((const LAS f32x4*)(C.lds + CB_B2))[C.lane + 64 * j];
        if (last) { if (row < NLAT) { f32x4* orow = (f32x4*)(((float*)C.kp->out) + (size_t)row * D) + C.lane;
#pragma unroll
            for (int j = 0; j < 4; ++j) orow[64 * j] = v[j]; } }
        else {
#pragma unroll
            for (int j = 0; j < 4; ++j) hr[64 * j] = v[j];
            ln_stats(v, mean, rstd, C.lane);
            const LAS f32x4* sh = (const LAS f32x4*)(C.lds + CB_SH + r * 4096) + C.lane; const LAS f32x4* sc = (const LAS f32x4*)(C.lds + CB_SC + r * 4096) + C.lane; u32x2* o = (u32x2*)(U + (size_t)row * D) + C.lane;
#pragma unroll
            for (int j = 0; j < 4; ++j) { const f32x4 yy = (v[j] - mean) * rstd * sc[64 * j] + sh[64 * j]; u32x2 w; w.x = pk2(yy.x, yy.y); w.y = pk2(yy.z, yy.w); o[64 * j] = w; } }
#pragma unroll
        for (int k = 0; k < 4; ++k)
#pragma unroll
            for (int j = 0; j < 4; ++j) yc[k][j] = yn[k][j];
#pragma unroll
        for (int j = 0; j < 4; ++j) hc[j] = hn[j];
        ppC = ppN; row = nrow;
    }
#undef CMB_IDX
#undef CMB_DATA
}

#ifndef USE_PG8
#define USE_PG8 1
#endif
#define RUN_GEMM(K_, S_, E_) gemm_pg8(C.lds, C.tid, K_, S_, E_)
constexpr int NCVT_L1 = 52, CVT_PER = 3, CVT_CHUNKS = 128, CVT_ITEMS = 32 * 8 * 8 + 32 * 8 * 4, CVT_CW = 20480;
constexpr int NCVT = 56;
__device__ __forceinline__ void phase_gemm_inproj(Ctx& C, int l) {
    PHASE_BEGIN(C); PIN_S(l);
    int nearly = 0;
    if (l == 1) { const int nc = __hip_atomic_load(WSP(int, WS_CTL) + CVT_CW, __ATOMIC_RELAXED, __HIP_MEMORY_SCOPE_AGENT); nearly = (nc < CVT_CHUNKS ? nc : CVT_CHUNKS) * CVT_PER; }
    const int ncvt = (CVT_ITEMS - nearly <= NCVT_L1 * 55) ? NCVT_L1 : NCVT; const int ngb = C.nb - ncvt;
    if (C.bid >= ngb) { phase0_transposes(C, 1, l, C.bid - ngb, ncvt, nearly); return; }
    const int nunits = l == 1 ? (NLAT / 256) * 26 + 24 : (T / 256) * 26;
    { SchedInProj S{WSP(bf16_t, WS_U), WSP(bf16_t, WS_WIN) + (size_t)l * PT * D, ngb, C.bid, l == 1 ? 1 : 0};
      EpiInProj E{WSP(bf16_t, WS_P), INP(7) + (size_t)l * PT, WSP(f32x2, WS_ROPE)};
      RUN_GEMM(D, S, E); }
    { SchedVT S{WSP(bf16_t, WS_WIN) + (size_t)l * PT * D + (size_t)C_V * D, WSP(bf16_t, WS_U), ngb, (C.bid + ngb - (nunits % ngb)) % ngb};
      EpiVT E{WSP(bf16_t, WS_VT), INP(7) + (size_t)l * PT + C_V};
      RUN_GEMM(D, S, E); }
}
template <int MODE>
__device__ __forceinline__ void tail_gemm(Ctx& C, int l) {
    PHASE_BEGIN(C); PIN_S(l);
    constexpr int K = MODE == 0 ? 2048 : 1024, KS = K / 8, PS = 64 * 68;
    const bf16_t* A = MODE == 0 ? WSP(bf16_t, WS_CAT) : WSP(bf16_t, WS_MERGED);
    const bf16_t* B = MODE == 0 ? WSP(bf16_t, WS_WCAT) + (size_t)l * D * 2048 : WSP(bf16_t, WS_WO) + (size_t)l * D * D;
    const int r = C.lane & 15, q = C.lane >> 4;
    LAS float* lf = (LAS float*)C.lds;
    __syncthreads();
#pragma unroll 1
    for (int tile = C.bid; tile < 256; tile += C.nb) {
        const int row0 = NLAT + (tile >> 4) * 64, col0 = (tile & 15) * 64, k0 = C.wave * KS + q * 8;
        const bf16_t* ap = A + (size_t)(row0 + r) * K + k0; const bf16_t* bp = B + (size_t)(col0 + r) * K + k0;
        f32x4 acc[4][4];
#pragma unroll
        for (int i = 0; i < 4; ++i)
#pragma unroll
            for (int j = 0; j < 4; ++j) acc[i][j] = f32x4{0.f, 0.f, 0.f, 0.f};
#pragma unroll 2
        for (int ks = 0; ks < KS / 32; ++ks) {
            bf16x8 a[4], b[4];
#pragma unroll
            for (int i = 0; i < 4; ++i) { a[i] = *(const bf16x8*)(ap + (size_t)i * 16 * K + ks * 32); b[i] = *(const bf16x8*)(bp + (size_t)i * 16 * K + ks * 32); }
#pragma unroll
            for (int i = 0; i < 4; ++i)
#pragma unroll
                for (int j = 0; j < 4; ++j) acc[i][j] = __builtin_amdgcn_mfma_f32_16x16x32_bf16(b[j], a[i], acc[i][j], 0, 0, 0);
        }
        LAS float* part = lf + C.wave * PS;
#pragma unroll
        for (int i = 0; i < 4; ++i)
#pragma unroll
            for (int j = 0; j < 4; ++j) *(LAS f32x4*)(part + (i * 16 + r) * 68 + j * 16 + 4 * q) = acc[i][j];
        __syncthreads();
        const int er = C.tid >> 3, ec = (C.tid & 7) * 8; const int row = row0 + er, col = col0 + ec;
        f32x4 p[8][2];
#pragma unroll
        for (int w = 0; w < 8; ++w)
#pragma unroll
            for (int h = 0; h < 2; ++h) p[w][h] = *(const LAS f32x4*)(lf + w * PS + er * 68 + ec + 4 * h);
        float o[8];
        if (MODE == 0) {
            const bf16_t* g = WSP(bf16_t, WS_P) + (size_t)row * PT + C_GL + col;
            float g0[8], g1[8], g2[8]; unpack8(*(const u32x4*)g, g0); unpack8(*(const u32x4*)(g + D), g1); unpack8(*(const u32x4*)(g + 2 * D), g2);
#pragma unroll
            for (int h = 0; h < 2; ++h) { const f32x4 sa = p[0][h] + p[1][h], sc = p[2][h] + p[3][h], sl = (p[4][h] + p[5][h]) + (p[6][h] + p[7][h]);
#pragma unroll
                for (int j = 0; j < 4; ++j) o[4 * h + j] = __builtin_amdgcn_rcpf(g0[4 * h + j]) * sa[j] + __builtin_amdgcn_rcpf(g1[4 * h + j]) * sc[j] + __builtin_amdgcn_rcpf(g2[4 * h + j]) * sl[j]; }
            *(u32x4*)(WSP(bf16_t, WS_MERGED) + (size_t)row * D + col) = pack8(o);
        } else {
            const float* hb = (l == 0 ? INP(2) - (size_t)NLAT * D : WSP(float, WS_H)) + (size_t)row * D + col;
            const float* g1 = WSP(float, WS_MOD) + (size_t)l * 5 * 6144 + 4 * 6144 + 2 * D + col; const float* bo = INP(21) + (size_t)l * D + col;
#pragma unroll
            for (int h = 0; h < 2; ++h) { const f32x4 y = ((p[0][h] + p[1][h]) + (p[2][h] + p[3][h])) + ((p[4][h] + p[5][h]) + (p[6][h] + p[7][h])) + *(const f32x4*)(bo + 4 * h);
                const f32x4 v = *(const f32x4*)(hb + 4 * h) * ALPHA + *(const f32x4*)(g1 + 4 * h) * y; o[4 * h] = v[0]; o[4 * h + 1] = v[1]; o[4 * h + 2] = v[2]; o[4 * h + 3] = v[3]; }
            *(u32x4*)(WSP(bf16_t, WS_V) + (size_t)row * D + col) = pack8(o);
        }
        __syncthreads();
    }
}
__device__ __forceinline__ void phase_gemm_proj(Ctx& C, int l) {
    PHASE_BEGIN(C); PIN_S(l);
    { Sched2D S{WSP(bf16_t, WS_CAT), WSP(bf16_t, WS_WCAT) + (size_t)l * D * 2048, NLAT / 256, D / 256, 2048, C.nb, C.bid};
      EpiMerge E{WSP(bf16_t, WS_MERGED), WSP(bf16_t, WS_P)};
      RUN_GEMM(2048, S, E); }
    if (l == 0) tail_gemm<0>(C, l);
}
__device__ __forceinline__ void phase_gemm_wo(Ctx& C, int l) {
    PHASE_BEGIN(C); PIN_S(l);
    { Sched2D S{WSP(bf16_t, WS_MERGED), WSP(bf16_t, WS_WO) + (size_t)l * D * D, NLAT / 256, D / 256, D, C.nb, C.bid};
      EpiWo E{l == 0 ? INP(0) : WSP(float, WS_H), l == 0 ? INP(2) - (size_t)NLAT * D : WSP(float, WS_H), WSP(bf16_t, WS_V), INP(21) + (size_t)l * D, WSP(float, WS_MOD) + (size_t)l * 5 * 6144};
      RUN_GEMM(D, S, E); }
    if (l == 0) tail_gemm<1>(C, l);
}
__device__ __forceinline__ void phase_gemm_moe(Ctx& C, int l) {
    PHASE_BEGIN(C); PIN_S(l);
    build_blk(C, l);
    LAS int* blk = (LAS int*)(C.lds + 131072);
    if (C.tid == 0) {
        unsigned* bar = (unsigned*)WSP(unsigned, WS_CTL) + 4096; const unsigned x = xb_xcc_id(); unsigned before = 0u, mine = 0u, tot = 0u;
        for (unsigned j = 0; j < 16; ++j) { const unsigned c = xb_ld(&bar[XB_XCNT(j)]); before += j < x ? c : 0u; mine = j == x ? c : mine; tot += c; }
        const unsigned R = (unsigned)blk[32]; const unsigned r0 = R * before / tot, r1 = R * (before + mine) / tot;
        blk[160] = (int)r0; blk[161] = (int)(r1 - r0); blk[162] = (int)mine; }
    __syncthreads();
    int* done = WSP(int, WS_CTL) + 16384 + l * 1024;
    SchedMoEF S{WSP(bf16_t, WS_U), WSP(bf16_t, WS_RB) + (size_t)NSLOT * D, WSP(bf16_t, WS_WGU) + (size_t)l * 32 * 2048 * D, WSP(bf16_t, WS_WDN) + (size_t)l * 32 * D * D, (const LAS int*)blk,
                WSP(int, WS_ETOK) + (size_t)l * 32 * ECAP, done, (int)((const LAS unsigned*)(C.lds + LDS_CTRL))[16], blk[162], blk[160], blk[161]};
    EpiMoE E{WSP(bf16_t, WS_RB) + (size_t)NSLOT * D, INP(27) + (size_t)l * 32 * 2048, WSP(bf16_t, WS_RA), INP(29) + (size_t)l * 32 * D, done};
    const int rk_ = S.rk, nxw_ = S.nxw, nrb_ = S.nrb;
    RUN_GEMM(D, S, E);
    if (l == 0) {
        PHASE_BEGIN(C);
        const int rem = (12 * nrb_) % nxw_;
        if (rem != 0 && rk_ >= rem) {
            LAS int* bw = (LAS int*)(C.lds + 131072) + 163;
            __syncthreads();
            if (C.tid == 0) *bw = atomicAdd(WSP(int, WS_CTL) + CVT_CW, 1);
            __syncthreads();
            const int chunk = *bw;
            if (chunk < CVT_CHUNKS) phase0_transposes(C, 1, 1, 0, 1, chunk * CVT_PER, chunk * CVT_PER + CVT_PER); } }
}

__global__ void __launch_bounds__(NTHR, 2) mega(Params p) {
    extern __shared__ __attribute__((aligned(16))) unsigned char lds_raw[];
    cg::grid_group grid = cg::this_grid();
    Ctx C; C.kp = (KP)__builtin_amdgcn_kernarg_segment_ptr(); C.tid = threadIdx.x; C.bid = blockIdx.x; C.nb = gridDim.x; C.lds = (LAS unsigned char*)lds_raw; C.ws = C.kp->ws;
    if (C.tid < 64) ((LAS unsigned*)(C.lds + LDS_CTRL))[C.tid] = 0u;
    __syncthreads();
    if (C.tid == 0) ((LAS unsigned*)(C.lds + LDS_CTRL))[16] = xb_add((unsigned*)WSP(unsigned, WS_CTL) + 4096 + XB_XCNT(xb_xcc_id()), 1u);
#define SYNC() do { PHASE_BEGIN(C); XcdBarrier bb_; bb_.bar = (unsigned*)WSP(unsigned, WS_CTL) + 4096; bb_.x = xb_xcc_id(); bb_.st = (volatile LAS unsigned*)(C.lds + LDS_CTRL); xcd_barrier(bb_); } while (0)
    phase0(C); grid.sync();
    phase_ln0(C, 0); SYNC();
#pragma unroll 1
    for (int l = 0; l < 2; ++l) {
        const bool last = (l == 1); const int nrows = last ? NLAT : T;
        phase_gemm_inproj(C, l); SYNC();
        phase_lru(C, l); phase_attn3(C, l, !last); SYNC();
        phase_gemm_proj(C, l); SYNC();
        phase_gemm_wo(C, l); SYNC();
        phase_ln1(C, l, nrows); SYNC();
        phase_gemm_moe(C, l); SYNC();
        phase_combine(C, l, nrows, last); SYNC();
    }
}

extern "C" void kernel_launch(void* const* d_in, const int* in_sizes, int n_in, void* d_out, int out_size, void* d_ws, size_t ws_size, hipStream_t stream) {
    static int grid_blocks = 0;
    if (!grid_blocks) {
        int dev = 0, cus = 0, per_cu = 0;
        (void)hipGetDevice(&dev);
        (void)hipDeviceGetAttribute(&cus, hipDeviceAttributeMultiprocessorCount, dev);
        (void)hipFuncSetAttribute((const void*)mega, hipFuncAttributeMaxDynamicSharedMemorySize, LDS_BYTES);
        (void)hipOccupancyMaxActiveBlocksPerMultiprocessor(&per_cu, (const void*)mega, NTHR, LDS_BYTES);
        if (per_cu < 1 || n_in != 32 || ws_size < WS_END) { fprintf(stderr, "kernel_launch: bad config per_cu %d n_in %d ws %zu\n", per_cu, n_in, ws_size); grid_blocks = -1; return; }
        grid_blocks = cus;
    }
    if (grid_blocks < 0) return;
    (void)hipMemsetAsync(d_ws, 0, 1 * MiB, stream);
    Params p{};
    for (int i = 0; i < 32; ++i) p.in[i] = (const GAS float*)d_in[i];
    p.out = (GAS float*)d_out; p.ws = (GAS unsigned char*)d_ws;
    void* args[] = {&p};
    hipError_t e = hipLaunchCooperativeKernel((void*)mega, dim3(grid_blocks), dim3(NTHR), args, LDS_BYTES, stream);
    if (e != hipSuccess) fprintf(stderr, "cooperative launch failed: %s (grid %d)\n", hipGetErrorString(e), grid_blocks);
}
```
